# Optimizing an MI355X kernel written in HIP

```python
import jax, jax.numpy as jnp
from jax import lax
import numpy as np

D_MODEL = 2048
BATCH = 2
SEQ = 16384
DEPTH = 4
DEC_BATCH = 16
DEC_SEQ = 64
PAST_LEN = 1024

CHUNK = 64
N_A_LAYERS = DEPTH // 2
N_B_LAYERS = DEPTH - N_A_LAYERS
EXPAND = 128
H_A = D_MODEL // EXPAND
K_A = EXPAND
V_A = D_MODEL // H_A
H_B = 16
D_HEAD_B = D_MODEL // H_B
QBLOCK = 128
D_PLE = 256
FORGET_BIAS_INIT = 3.0
EPS = 1e-6

kernel_name = "yoco_hgrn2_fox_stream_step"


def rmsnorm(x, g):
    xf = x.astype(jnp.float32)
    y = xf * lax.rsqrt(jnp.mean(xf * xf, axis=-1, keepdims=True) + EPS)
    return (y * g.astype(jnp.float32)).astype(x.dtype)


def hgrn2_chunk(S, inp):
    q, k, g, v = inp
    L = q.shape[2]
    G = jnp.cumsum(g, axis=2)
    causal = jnp.tril(jnp.ones((L, L), dtype=bool))
    diff = G[:, :, :, None, :] - G[:, :, None, :, :]
    decay = jnp.exp(jnp.where(causal[:, :, None], diff, -jnp.inf))
    A = jnp.einsum('bhtk,bhsk,bhtsk->bhts', q, k, decay)
    o = jnp.einsum('bhts,bhsv->bhtv', A, v) + jnp.einsum('bhtk,bhkv->bhtv', q * jnp.exp(G), S)
    G_last = G[:, :, -1:, :]
    S_new = jnp.exp(G_last[:, :, 0, :])[..., None] * S + jnp.einsum(
        'bhsk,bhsv->bhkv', k * jnp.exp(G_last - G), v)
    return S_new, o


def hgrn2_layer(x, S0, g_norm, w_in, lb, g_out, w_out):
    B, T, _ = x.shape
    z = rmsnorm(x, g_norm) @ w_in
    q, fl, i, gate = jnp.split(z, 4, axis=-1)
    lbf = lb.astype(jnp.float32)
    f = lbf + (1.0 - lbf) * jax.nn.sigmoid(fl.astype(jnp.float32))
    g = jnp.log(f)
    k = 1.0 - f
    q = jax.nn.silu(q.astype(jnp.float32))
    L = min(CHUNK, T)
    nc = T // L

    def blocks(a, d):
        a = a.astype(jnp.float32).reshape(B, nc, L, H_A, d)
        return jnp.transpose(a, (1, 0, 3, 2, 4))

    S_fin, o = lax.scan(hgrn2_chunk, S0.astype(jnp.float32),
                        (blocks(q, K_A), blocks(k, K_A), blocks(g, K_A), blocks(i, V_A)))
    o = jnp.transpose(o, (1, 0, 3, 2, 4)).reshape(B, T, H_A, V_A)
    o = o * lax.rsqrt(jnp.mean(o * o, axis=-1, keepdims=True) + EPS)
    o = o.reshape(B, T, D_MODEL) * g_out.astype(jnp.float32)
    y = (o * jax.nn.silu(gate.astype(jnp.float32))).astype(x.dtype) @ w_out
    return x + y, S_fin


def shared_kv(x, g_kv, w_kv, b_f):
    B, T, _ = x.shape
    z = rmsnorm(x, g_kv) @ w_kv
    k = z[..., :D_MODEL].reshape(B, T, H_B, D_HEAD_B)
    v = z[..., D_MODEL:2 * D_MODEL].reshape(B, T, H_B, D_HEAD_B)
    logf = jax.nn.log_sigmoid(z[..., 2 * D_MODEL:].astype(jnp.float32) + b_f.astype(jnp.float32))
    return k, v, logf


def fox_attention(q, k_all, v_all, dq, dkT, q_off):
    B, T, H, Dh = q.shape
    Lk = k_all.shape[1]
    k_pos = jnp.arange(Lk)
    blk = min(QBLOCK, T)
    nb = T // blk
    qb = jnp.moveaxis(q.reshape(B, nb, blk, H, Dh), 1, 0)
    dqb = jnp.moveaxis(dq.reshape(B, nb, blk, H), 1, 0)
    pos = (q_off + jnp.arange(T)).reshape(nb, blk)
    scale = Dh ** -0.5

    def one_block(args):
        qi, dqi, pi = args
        s = jnp.einsum('bqhd,bkhd->bhqk', qi, k_all, preferred_element_type=jnp.float32) * scale
        s = s + jnp.transpose(dqi, (0, 2, 1))[..., None] - dkT[:, :, None, :]
        mask = k_pos[None, :] <= pi[:, None]
        s = jnp.where(mask, s, -jnp.inf)
        pr = jax.nn.softmax(s, axis=-1)
        return jnp.einsum('bhqk,bkhd->bqhd', pr.astype(v_all.dtype), v_all)

    o = lax.map(one_block, (qb, dqb, pos))
    return jnp.moveaxis(o, 0, 1).reshape(B, T, H, Dh)


def fox_layer(x, k_all, v_all, dq, dkT, q_off, g_norm, w_in, w_out):
    B, T, _ = x.shape
    z = rmsnorm(x, g_norm) @ w_in
    q, gate = jnp.split(z, 2, axis=-1)
    o = fox_attention(q.reshape(B, T, H_B, D_HEAD_B), k_all, v_all, dq, dkT, q_off)
    o = o.reshape(B, T, D_MODEL).astype(jnp.float32) * jax.nn.silu(gate.astype(jnp.float32))
    return x + o.astype(x.dtype) @ w_out


def ple_add(x, p_i, w_pin, g_pg, w_pg):
    e = (p_i @ w_pin).astype(jnp.float32)
    gate = jax.nn.sigmoid((rmsnorm(x, g_pg) @ w_pg).astype(jnp.float32))
    return x + (gate * e).astype(x.dtype)


def trunk(x, p, hgrn_s0, past_k, past_v, past_logf,
          g_norm_a, w_in_a, lb_logits, g_out_a, w_out_a, g_kv, w_kv, b_f,
          g_norm_b, w_in_b, w_out_b, w_ple_in, g_ple, w_ple_gate, g_final):
    lbs = jnp.cumsum(jax.nn.softmax(lb_logits.astype(jnp.float32), axis=0), axis=0)
    lbs = lbs - lbs[:1]
    hgrn_states = []
    for layer in range(DEPTH):
        if layer < N_A_LAYERS:
            x, s = hgrn2_layer(x, hgrn_s0[layer], g_norm_a[layer], w_in_a[layer], lbs[layer],
                               g_out_a[layer], w_out_a[layer])
            hgrn_states.append(s)
        else:
            j = layer - N_A_LAYERS
            x = fox_layer(x, k_all, v_all, dq, dkT, q_off, g_norm_b[j], w_in_b[j], w_out_b[j])
        x = ple_add(x, p[layer], w_ple_in[layer], g_ple[layer], w_ple_gate[layer])
        if layer == N_A_LAYERS - 1:
            k_new, v_new, logf_new = shared_kv(x, g_kv, w_kv, b_f)
            if past_k is None:
                k_all, v_all, logf_all, q_off = k_new, v_new, logf_new, 0
            else:
                k_all = jnp.concatenate([past_k.astype(k_new.dtype), k_new], axis=1)
                v_all = jnp.concatenate([past_v.astype(v_new.dtype), v_new], axis=1)
                logf_all = jnp.concatenate([past_logf.astype(jnp.float32), logf_new], axis=1)
                q_off = past_k.shape[1]
            dcum = jnp.cumsum(logf_all, axis=1)
            dq = dcum[:, q_off:]
            dkT = jnp.transpose(dcum, (0, 2, 1))
    y = rmsnorm(x, g_final)
    return y, jnp.stack(hgrn_states), k_new, v_new, logf_new


def setup_inputs(seed: int = 0) -> dict:
    key = jax.random.key(seed)
    ks = jax.random.split(key, 32)
    f32 = jnp.float32

    def nrm(k, shape, scale):
        return jax.random.normal(k, shape, f32) * scale

    D = D_MODEL
    return {
        "x_prompt": nrm(ks[0], (BATCH, SEQ, D), 1.0),
        "x_sample": nrm(ks[1], (DEC_BATCH, DEC_SEQ, D), 1.0),
        "state_hgrn": nrm(ks[2], (N_A_LAYERS, DEC_BATCH, H_A, K_A, V_A), 0.5),
        "cache_k": nrm(ks[3], (DEC_BATCH, PAST_LEN, H_B, D_HEAD_B), 1.0),
        "cache_v": nrm(ks[4], (DEC_BATCH, PAST_LEN, H_B, D_HEAD_B), 1.0),
        "cache_logf": jax.nn.log_sigmoid(FORGET_BIAS_INIT + nrm(ks[5], (DEC_BATCH, PAST_LEN, H_B), 1.0)),
        "p_prompt": nrm(ks[6], (DEPTH, BATCH, SEQ, D_PLE), 1.0),
        "p_sample": nrm(ks[7], (DEPTH, DEC_BATCH, DEC_SEQ, D_PLE), 1.0),
        "g_norm_a": 1.0 + nrm(ks[8], (N_A_LAYERS, D), 0.01),
        "w_in_a": nrm(ks[9], (N_A_LAYERS, D, 4 * D), D ** -0.5),
        "lb_logits": nrm(ks[10], (N_A_LAYERS, D), 1.0),
        "g_out_a": 1.0 + nrm(ks[11], (N_A_LAYERS, D), 0.01),
        "w_out_a": nrm(ks[12], (N_A_LAYERS, D, D), D ** -0.5),
        "g_kv": 1.0 + nrm(ks[13], (D,), 0.01),
        "w_kv": nrm(ks[14], (D, 2 * D + H_B), D ** -0.5),
        "b_f": FORGET_BIAS_INIT + nrm(ks[15], (H_B,), 0.1),
        "g_norm_b": 1.0 + nrm(ks[16], (N_B_LAYERS, D), 0.01),
        "w_in_b": nrm(ks[17], (N_B_LAYERS, D, 2 * D), D ** -0.5),
        "w_out_b": nrm(ks[18], (N_B_LAYERS, D, D), D ** -0.5),
        "w_ple_in": nrm(ks[19], (DEPTH, D_PLE, D), D_PLE ** -0.5),
        "g_ple": 1.0 + nrm(ks[20], (DEPTH, D), 0.01),
        "w_ple_gate": nrm(ks[21], (DEPTH, D, D), D ** -0.5),
        "g_final": 1.0 + nrm(ks[22], (D,), 0.01),
    }


def reference(x_prompt, x_sample, state_hgrn, cache_k, cache_v, cache_logf, p_prompt, p_sample,
              g_norm_a, w_in_a, lb_logits, g_out_a, w_out_a, g_kv, w_kv, b_f,
              g_norm_b, w_in_b, w_out_b, w_ple_in, g_ple, w_ple_gate, g_final):
    s0_prompt = jnp.zeros((N_A_LAYERS, x_prompt.shape[0], H_A, K_A, V_A), jnp.float32)
    y_prompt, state_hgrn_prompt, k_prompt, v_prompt, logf_prompt = trunk(
        x_prompt, p_prompt, s0_prompt, None, None, None,
        g_norm_a, w_in_a, lb_logits, g_out_a, w_out_a, g_kv, w_kv, b_f,
        g_norm_b, w_in_b, w_out_b, w_ple_in, g_ple, w_ple_gate, g_final)
    y_sample, state_hgrn_sample, k_sample, v_sample, logf_sample = trunk(
        x_sample, p_sample, state_hgrn, cache_k, cache_v, cache_logf,
        g_norm_a, w_in_a, lb_logits, g_out_a, w_out_a, g_kv, w_kv, b_f,
        g_norm_b, w_in_b, w_out_b, w_ple_in, g_ple, w_ple_gate, g_final)
    return (y_prompt, y_sample, state_hgrn_prompt, state_hgrn_sample,
            k_prompt, v_prompt, logf_prompt, k_sample, v_sample, logf_sample)
```

```cpp
#ifndef EMU_HOST
#include <hip/hip_runtime.h>
#endif
#include <cstdio>
#include <cstdint>

constexpr int D = 2048, H = 16, HD = 128, DPLE = 256;
constexpr int NBP = 2, TP = 16384, MP = NBP * TP;
constexpr int NBS = 16, TS = 64, MS = NBS * TS;
constexpr int M = MP + MS;
constexpr int PAST = 1024, LKS = PAST + TS;
constexpr int NSEG = 16, SEGC = 16, CH = 64;
constexpr int NKVQ = 8448;
constexpr float EPS = 1e-6f;
constexpr float LOG2E = 1.4426950408889634f;

constexpr size_t O_YP = 0, O_YS = O_YP + (size_t)MP * D, O_STP = O_YS + (size_t)MS * D, O_STS = O_STP + (size_t)2 * NBP * H * HD * HD,
                 O_KP = O_STS + (size_t)2 * NBS * H * HD * HD, O_VP = O_KP + (size_t)MP * D, O_LFP = O_VP + (size_t)MP * D, O_KS = O_LFP + (size_t)MP * H,
                 O_VS = O_KS + (size_t)MS * D, O_LFS = O_VS + (size_t)MS * D, O_END = O_LFS + (size_t)MS * H;
static_assert(O_END == 217595904ull, "output size");

constexpr size_t MiB = 1u << 20;
constexpr size_t WS_CTL = 0, CTL_ZERO_BYTES = 3 * MiB;
constexpr size_t WS_SS = 1 * MiB;
constexpr size_t WS_LBV = 3 * MiB;
constexpr size_t WS_GSEG = 3 * MiB + 64 * 1024;
constexpr size_t WS_DP = 4 * MiB, WS_DS = 6 * MiB, WS_LF = 8 * MiB;
constexpr size_t WS_WAIN = 12 * MiB, WS_WAOUT = 76 * MiB, WS_WKVQ = 92 * MiB, WS_WBIN1 = 125 * MiB, WS_WBOUT = 141 * MiB, WS_WPIN = 157 * MiB, WS_WPG = 161 * MiB;
constexpr size_t WS_X = 193 * MiB, WS_XB = 457 * MiB, WS_ZQ = 589 * MiB, WS_ZG = 721 * MiB, WS_ZV = 853 * MiB, WS_ZGATE = 985 * MiB, WS_OB = 1117 * MiB, WS_EB = 1249 * MiB;
constexpr size_t WS_PB = 1381 * MiB, WS_KS = 1447 * MiB, WS_VS = 1515 * MiB, WS_LSEG = 1583 * MiB, WS_SSTART = 1615 * MiB, WS_XB2 = 1647 * MiB, WS_END = 1779 * MiB;
constexpr size_t WS_KP = WS_ZG, WS_VP = WS_ZV;
static_assert(WS_SS + 9ull * M * 4 <= CTL_ZERO_BYTES && (size_t)M * D * 2 == 132 * MiB && (size_t)NKVQ * D * 2 <= 33 * MiB && (size_t)NBS * LKS * D * 2 <= 68 * MiB, "ws map");
constexpr int CW_TMO = 0, CW_BAR = 4096;

constexpr int RING_BYTES = 131072, LDSCTL_OFF = RING_BYTES, MISC_OFF = LDSCTL_OFF + 320, LDS_BYTES = 147456, NWAVES = 8;

typedef unsigned short bf16_t;
typedef short bf16x8 __attribute__((ext_vector_type(8)));
typedef float f32x4 __attribute__((ext_vector_type(4)));
typedef float f32x2 __attribute__((ext_vector_type(2)));
typedef unsigned u32x4 __attribute__((ext_vector_type(4)));
typedef unsigned u32x2 __attribute__((ext_vector_type(2)));
typedef _Float16 h16x2 __attribute__((ext_vector_type(2)));

#ifndef EMU_HOST
#define DEV __device__ __forceinline__
#define GAS __attribute__((address_space(1)))
#define LAS __attribute__((address_space(3)))
#define BLOCK_SYNC() __syncthreads()
#define SHFL_XOR(v, m) __shfl_xor((v), (m))
#define MFMA16(a, b, c) __builtin_amdgcn_mfma_f32_16x16x32_bf16((a), (b), (c), 0, 0, 0)
#define ATOMIC_ADD_F32(p, v) ((void)__hip_atomic_fetch_add((p), (v), __ATOMIC_RELAXED, __HIP_MEMORY_SCOPE_AGENT))
DEV float fexp(float x) { return __expf(x); }
DEV float fexp2(float x) { return __builtin_amdgcn_exp2f(x); }
DEV float flog(float x) { return __logf(x); }
DEV float frcp(float x) { return __builtin_amdgcn_rcpf(x); }
DEV float frsq(float x) { return __builtin_amdgcn_rsqf(x); }
DEV unsigned pk2(float lo, float hi) { unsigned r; asm volatile("v_cvt_pk_bf16_f32 %0, %1, %2" : "=v"(r) : "v"(lo), "v"(hi)); return r; }
#endif
DEV float bf_lo(unsigned w) { return __builtin_bit_cast(float, w << 16); }
DEV float bf_hi(unsigned w) { return __builtin_bit_cast(float, w & 0xffff0000u); }
DEV float bf2f(bf16_t b) { return __builtin_bit_cast(float, (unsigned)b << 16); }
DEV unsigned pkh2(float lo, float hi) { h16x2 t = {(_Float16)lo, (_Float16)hi}; return __builtin_bit_cast(unsigned, t); }
DEV float h_lo(unsigned w) { h16x2 t = __builtin_bit_cast(h16x2, w); return (float)t.x; }
DEV float h_hi(unsigned w) { h16x2 t = __builtin_bit_cast(h16x2, w); return (float)t.y; }
DEV float sigmoidf_(float z) { return frcp(1.0f + fexp(-z)); }
DEV float siluf_(float z) { return z * frcp(1.0f + fexp(-z)); }

#ifndef EMU_HOST
namespace pg8 {
#define PG8_LAS __attribute__((address_space(3)))
typedef unsigned short bf16_t;
typedef short bf16x8 __attribute__((ext_vector_type(8)));
typedef float f32x4 __attribute__((ext_vector_type(4)));
typedef unsigned u32x4 __attribute__((ext_vector_type(4)));
constexpr int BM = 256, BK = 64, HALF = 128, HTB = HALF * BK * 2  , STAGE_BYTES = 8 * HTB, NXCD = 8, WGM = 8;

__host__ __device__ __forceinline__ int lds_byte(int r, int c) { const int st = (r >> 4) * 2 + (c >> 5), rr = r & 15, cc = c & 31, ob = rr * 64 + cc * 2; return st * 1024 + (ob ^ (((ob >> 9) & 1) << 5)); }
__host__ __device__ __forceinline__ void stage_rc(int b, int& R, int& C) { const int st = b / 1024, sb = b % 1024, swz = sb ^ (((sb >> 9) & 1) << 5); R = (st >> 1) * 16 + swz / 64; C = (st & 1) * 32 + (swz % 64) / 2; }
__host__ __device__ __forceinline__ int perm32(int rho) { const int n = rho >> 4, i = rho & 15; return 8 * (i >> 2) + 4 * n + (i & 3); }

struct Unit { int pm, pn; };
struct Gemm { const bf16_t* A; const bf16_t* Bt; int M, N, K; };

struct StaticOrder {
    int nM, nN, nwg, G, c;
    __host__ __device__ void init(int M, int N, int G_, int c_) { nM = M / BM; nN = N / BM; nwg = nM * nN; G = G_; c = c_; }
    __host__ __device__ bool next(int i, Unit& u) const {
        const long L = (long)i * G + c; if (L >= nwg) return false;
        int wgid = (int)L; { const int q = nwg / NXCD, r = nwg % NXCD, xcd = wgid % NXCD, off = wgid / NXCD; wgid = (xcd < r ? xcd * (q + 1) : r * (q + 1) + (xcd - r) * q) + off; }
        const int nig = WGM * nN, gid = wgid / nig, fm = gid * WGM, gsz = (nM - fm) < WGM ? (nM - fm) : WGM;
        u.pm = fm + ((wgid % nig) % gsz); u.pn = (wgid % nig) / gsz; return true;
    }
    __device__ __forceinline__ void a_ready(const Unit&) const {}
    __device__ __forceinline__ void done(const Unit&) const {}
};

__device__ __forceinline__ unsigned cvt_pk_bf16(float lo, float hi) { unsigned r; asm volatile("v_cvt_pk_bf16_f32 %0, %1, %2" : "=v"(r) : "v"(lo), "v"(hi)); return r; }
typedef float f32x2 __attribute__((ext_vector_type(2)));

struct EpiBf16 {
    static constexpr bool PERM = true, AFTER_DRAIN = false;
    bf16_t* O; int ldc;
    __device__ __forceinline__ void operator()(const f32x4 (&acc)[2][2][4][2], const Unit& u, int wr, int wc, int fr, int fq) const {
        const int row0 = u.pm * BM + wr * 64 + fr, col0 = u.pn * BM + wc * 32 + 8 * fq;
#pragma unroll
        for (int ai = 0; ai < 2; ++ai)
#pragma unroll
            for (int m = 0; m < 4; ++m) { bf16_t* rowp = O + (size_t)(row0 + ai * HALF + m * 16) * ldc + col0;
#pragma unroll
                for (int bj = 0; bj < 2; ++bj) { const f32x4 v0 = acc[ai][bj][m][0], v1 = acc[ai][bj][m][1];
                    u32x4 w; w.x = cvt_pk_bf16(v0[0], v0[1]); w.y = cvt_pk_bf16(v0[2], v0[3]); w.z = cvt_pk_bf16(v1[0], v1[1]); w.w = cvt_pk_bf16(v1[2], v1[3]);
                    *(u32x4*)(rowp + bj * HALF) = w; } }
    }
};

struct EpiAin {
    static constexpr bool PERM = true, AFTER_DRAIN = false;
    const float* ss; const float* lb; bf16_t* zq; bf16_t* zg; bf16_t* zv; bf16_t* zgate;
    template <int TYPE> __device__ __forceinline__ void run(const f32x4 (&acc)[2][2][4][2], const Unit& u, int wr, int wc, int fr, int fq, bf16_t* base) const {
        const int ct = (u.pn & 7) * BM + wc * 32 + 8 * fq, row0 = u.pm * BM + wr * 64 + fr;
#pragma unroll
        for (int ai = 0; ai < 2; ++ai)
#pragma unroll
            for (int m = 0; m < 4; ++m) { const int row = row0 + ai * HALF + m * 16; const float rstd = frsq(ss[row] * (1.0f / D) + EPS);
                bf16_t* rowp = base + (size_t)row * D + ct;
#pragma unroll
                for (int bj = 0; bj < 2; ++bj) { f32x4 v0 = acc[ai][bj][m][0] * rstd, v1 = acc[ai][bj][m][1] * rstd; u32x4 w;
                    if (TYPE == 1) {
                        const f32x4 l0 = *(const f32x4*)(lb + ct + bj * HALF), l1 = *(const f32x4*)(lb + ct + bj * HALF + 4);
#pragma unroll
                        for (int j = 0; j < 4; ++j) { v0[j] = fmaxf(flog(l0[j] + (1.0f - l0[j]) * sigmoidf_(v0[j])), -80.0f); v1[j] = fmaxf(flog(l1[j] + (1.0f - l1[j]) * sigmoidf_(v1[j])), -80.0f); }
                        w.x = pkh2(v0[0], v0[1]); w.y = pkh2(v0[2], v0[3]); w.z = pkh2(v1[0], v1[1]); w.w = pkh2(v1[2], v1[3]);
                    } else {
                        if (TYPE == 0) {
#pragma unroll
                            for (int j = 0; j < 4; ++j) { v0[j] = siluf_(v0[j]); v1[j] = siluf_(v1[j]); } }
                        w.x = cvt_pk_bf16(v0[0], v0[1]); w.y = cvt_pk_bf16(v0[2], v0[3]); w.z = cvt_pk_bf16(v1[0], v1[1]); w.w = cvt_pk_bf16(v1[2], v1[3]);
                    }
                    *(u32x4*)(rowp + bj * HALF) = w; } }
    }
    __device__ __forceinline__ void operator()(const f32x4 (&acc)[2][2][4][2], const Unit& u, int wr, int wc, int fr, int fq) const {
        const int type = u.pn >> 3;
        if (type == 0) run<0>(acc, u, wr, wc, fr, fq, zq); else if (type == 1) run<1>(acc, u, wr, wc, fr, fq, zg); else if (type == 2) run<2>(acc, u, wr, wc, fr, fq, zv); else run<0>(acc, u, wr, wc, fr, fq, zgate);
    }
};

struct EpiBin {
    static constexpr bool PERM = true, AFTER_DRAIN = false;
    const float* ss; int tbase; bf16_t* kp; bf16_t* vp; bf16_t* ks; bf16_t* vs; bf16_t* zq; bf16_t* zgate; float* out; float* lf; const float* bf;
    template <int TYPE> __device__ __forceinline__ void run(const f32x4 (&acc)[2][2][4][2], const Unit& u, int wr, int wc, int fr, int fq) const {
        const int ct = (u.pn & 7) * BM + wc * 32 + 8 * fq, row0 = u.pm * BM + wr * 64 + fr; const bool smp = u.pm >= MP / BM;
#pragma unroll
        for (int ai = 0; ai < 2; ++ai)
#pragma unroll
            for (int m = 0; m < 4; ++m) { const int row = row0 + ai * HALF + m * 16; const float rstd = frsq(ss[row] * (1.0f / D) + EPS);
                const int ms = row - MP;
                if (TYPE == 4) {
                    if (wc == 0 && fq < 2) { const f32x4 v0 = acc[ai][0][m][0] * rstd + *(const f32x4*)(bf + 8 * fq), v1 = acc[ai][0][m][1] * rstd + *(const f32x4*)(bf + 8 * fq + 4); f32x4 r0, r1;
#pragma unroll
                        for (int j = 0; j < 4; ++j) { r0[j] = fminf(v0[j], 0.f) - log1pf(expf(-fabsf(v0[j]))); r1[j] = fminf(v1[j], 0.f) - log1pf(expf(-fabsf(v1[j]))); }
                        float* o = smp ? out + O_LFS + (size_t)ms * H + 8 * fq : out + O_LFP + (size_t)row * H + 8 * fq; float* l = lf + (size_t)row * H + 8 * fq;
                        *(f32x4*)o = r0; *(f32x4*)(o + 4) = r1; *(f32x4*)l = r0; *(f32x4*)(l + 4) = r1; }
                } else {
                    bf16_t* rowp; float* orow = nullptr;
                    if (TYPE == 0 || TYPE == 1) {
                        if (smp) { const size_t kr = (size_t)(ms / TS) * LKS + PAST + (ms % TS); rowp = (TYPE == 0 ? ks : vs) + kr * D + ct; orow = out + (TYPE == 0 ? O_KS : O_VS) + (size_t)ms * D + ct; }
                        else { rowp = (TYPE == 0 ? kp : vp) + (size_t)row * D + ct; orow = out + (TYPE == 0 ? O_KP : O_VP) + (size_t)row * D + ct; }
                    } else rowp = (TYPE == 2 ? zq : zgate) + (size_t)row * D + ct;
#pragma unroll
                    for (int bj = 0; bj < 2; ++bj) { f32x4 v0 = acc[ai][bj][m][0] * rstd, v1 = acc[ai][bj][m][1] * rstd;
                        if (TYPE == 0 || TYPE == 1) { *(f32x4*)(orow + bj * HALF) = v0; *(f32x4*)(orow + bj * HALF + 4) = v1; }
                        if (TYPE == 3) {
#pragma unroll
                            for (int j = 0; j < 4; ++j) { v0[j] = siluf_(v0[j]); v1[j] = siluf_(v1[j]); } }
                        u32x4 w; w.x = cvt_pk_bf16(v0[0], v0[1]); w.y = cvt_pk_bf16(v0[2], v0[3]); w.z = cvt_pk_bf16(v1[0], v1[1]); w.w = cvt_pk_bf16(v1[2], v1[3]);
                        *(u32x4*)(rowp + bj * HALF) = w; }
                } }
    }
    __device__ __forceinline__ void operator()(const f32x4 (&acc)[2][2][4][2], const Unit& u, int wr, int wc, int fr, int fq) const {
        const int type = (u.pn >> 3) + tbase;
        if (type == 0) run<0>(acc, u, wr, wc, fr, fq); else if (type == 1) run<1>(acc, u, wr, wc, fr, fq); else if (type == 2) run<2>(acc, u, wr, wc, fr, fq); else if (type == 3) run<3>(acc, u, wr, wc, fr, fq); else run<4>(acc, u, wr, wc, fr, fq);
    }
};

template <bool PLE> struct EpiRes {
    static constexpr bool PERM = false, AFTER_DRAIN = false;
    const float* xin_p; const float* xin_s; float* xout_p; float* xout_s; bf16_t* xb; float* ss_out; const float* ss_in; const bf16_t* e;
    __device__ __forceinline__ void operator()(const f32x4 (&acc)[2][2][4][2], const Unit& u, int wr, int wc, int fr, int fq) const {
        const int row0 = u.pm * BM + wr * 64 + fr, col0 = u.pn * BM + wc * 32 + 4 * fq; const bool smp = u.pm >= MP / BM;
        const float* xi = smp ? xin_s : xin_p; float* xo = smp ? xout_s : xout_p; const int rsub = smp ? MP : 0;
        float sacc[8];
#pragma unroll
        for (int ai = 0; ai < 2; ++ai)
#pragma unroll
            for (int m = 0; m < 4; ++m) { const int row = row0 + ai * HALF + m * 16; const size_t off = (size_t)row * D + col0, offx = (size_t)(row - rsub) * D + col0;
                float rstd = 1.f; if (PLE) rstd = frsq(ss_in[row] * (1.0f / D) + EPS);
                float s = 0.f;
#pragma unroll
                for (int bj = 0; bj < 2; ++bj)
#pragma unroll
                    for (int n = 0; n < 2; ++n) { const int o = bj * HALF + n * 16; const f32x4 xv = *(const f32x4*)(xi + offx + o); f32x4 a = acc[ai][bj][m][n];
                        if (PLE) { const u32x2 ev = *(const u32x2*)(e + off + o); a = a * rstd;
                            a[0] = sigmoidf_(a[0]) * bf_lo(ev.x); a[1] = sigmoidf_(a[1]) * bf_hi(ev.x); a[2] = sigmoidf_(a[2]) * bf_lo(ev.y); a[3] = sigmoidf_(a[3]) * bf_hi(ev.y); }
                        const f32x4 xn = xv + a; *(f32x4*)(xo + offx + o) = xn;
                        u32x2 w; w.x = cvt_pk_bf16(xn[0], xn[1]); w.y = cvt_pk_bf16(xn[2], xn[3]); *(u32x2*)(xb + off + o) = w;
                        s += (xn[0] * xn[0] + xn[1] * xn[1]) + (xn[2] * xn[2] + xn[3] * xn[3]); }
                s += __shfl_xor(s, 16); s += __shfl_xor(s, 32); sacc[ai * 4 + m] = s; }
#pragma unroll
        for (int j = 0; j < 2; ++j) { const float v = fq == 0 ? sacc[4 * j] : fq == 1 ? sacc[4 * j + 1] : fq == 2 ? sacc[4 * j + 2] : sacc[4 * j + 3];
            __hip_atomic_fetch_add(ss_out + row0 + j * HALF + fq * 16, v, __ATOMIC_RELAXED, __HIP_MEMORY_SCOPE_AGENT); }
    }
};

template <class Epi, class Sched, bool ALIGN_EPI = false, bool SP2 = false>
__device__ __forceinline__ void gemm_phase(PG8_LAS unsigned char* lds, const Gemm g, const Sched& S, const Epi& E) {
    int tid_ = threadIdx.x; asm volatile("" : "+v"(tid_));
    const int tid = tid_, wid = __builtin_amdgcn_readfirstlane(tid >> 6), lane = tid & 63, wr = wid >> 2, wc = wid & 3, fr = lane & 15, fq = lane >> 4;
    const int K = g.K, nt = K / BK;
    unsigned voffA[2], voffB[2];
#pragma unroll
    for (int i = 0; i < 2; ++i) { int R, C; stage_rc(tid * 16 + i * 8192, R, C); const int Rb = Epi::PERM ? ((R & ~31) + perm32(R & 31)) : R;
        voffA[i] = (unsigned)(R * K + C) * 2u; voffB[i] = (unsigned)(Rb * K + C) * 2u; }
    const size_t kstep = (size_t)(BK * 2);
    const size_t hstep = (size_t)HALF * K * 2;
    const size_t tstep = 2 * hstep;
    const unsigned ldsw = (unsigned)wid * 1024u;
    const int aoff = lds_byte(wr * 64 + fr, fq * 8), boff = lds_byte(wc * 32 + fr, fq * 8);
#define PG8_SA(b, h) (((b) * 2 + (h)) * HTB)
#define PG8_SB(b, h) ((4 + (b) * 2 + (h)) * HTB)
#define PG8_STAGE(bufoff, gbase, voff) do { _Pragma("unroll") for (int _i = 0; _i < 2; ++_i) \
        __builtin_amdgcn_global_load_lds((const unsigned*)((const char*)(gbase) + (voff)[_i]), (PG8_LAS unsigned*)(lds + (bufoff) + ldsw + _i * 8192), 16, 0, 0); } while (0)
#define PG8_LDA(dst, b, h) do { _Pragma("unroll") for (int m = 0; m < 4; ++m) _Pragma("unroll") for (int k = 0; k < 2; ++k) dst[m][k] = *(const PG8_LAS bf16x8*)(lds + PG8_SA(b, h) + aoff + m * 2048 + k * 1024); } while (0)
#define PG8_LDB(dst, b, h) do { _Pragma("unroll") for (int n = 0; n < 2; ++n) _Pragma("unroll") for (int k = 0; k < 2; ++k) dst[n][k] = *(const PG8_LAS bf16x8*)(lds + PG8_SB(b, h) + boff + n * 2048 + k * 1024); } while (0)
#define PG8_MMA(ai, bj, At, Bt) do { __builtin_amdgcn_s_setprio(1); _Pragma("unroll") for (int m = 0; m < 4; ++m) _Pragma("unroll") for (int n = 0; n < 2; ++n) _Pragma("unroll") for (int k = 0; k < 2; ++k) \
        acc[ai][bj][m][n] = __builtin_amdgcn_mfma_f32_16x16x32_bf16(Bt[n][k], At[m][k], acc[ai][bj][m][n], 0, 0, 0); __builtin_amdgcn_s_setprio(0); } while (0)
#define PG8_WAIT_V(n) asm volatile("s_waitcnt vmcnt(" #n ")" ::: "memory")
#define PG8_WAIT_L(n) asm volatile("s_waitcnt lgkmcnt(" #n ")" ::: "memory")
#define PG8_BAR __builtin_amdgcn_s_barrier()
#define PG8_SCHED __builtin_amdgcn_sched_barrier(0)
    Unit cur, nxt; int ui = 0;
    if (!S.next(0, cur)) return;
    f32x4 acc[2][2][4][2];
#pragma unroll
    for (int a = 0; a < 2; ++a)
#pragma unroll
        for (int b = 0; b < 2; ++b)
#pragma unroll
            for (int m = 0; m < 4; ++m)
#pragma unroll
                for (int n = 0; n < 2; ++n) acc[a][b][m][n] = (f32x4){0.f, 0.f, 0.f, 0.f};
    bf16x8 At[4][2], B0[2][2], B1[2][2];
    const char* cA = (const char*)g.A + (size_t)cur.pm * tstep; const char* cB = (const char*)g.Bt + (size_t)cur.pn * tstep;
    S.a_ready(cur);
    if constexpr (SP2) {
        PG8_STAGE(PG8_SB(0, 0), cB, voffB); PG8_STAGE(PG8_SB(0, 1), cB + hstep, voffB); PG8_STAGE(PG8_SA(0, 0), cA, voffA); PG8_STAGE(PG8_SA(0, 1), cA + hstep, voffA);
        if (wr == 1) PG8_BAR;
        PG8_WAIT_V(2); PG8_BAR;
        PG8_STAGE(PG8_SB(1, 0), cB + kstep, voffB); PG8_STAGE(PG8_SA(1, 0), cA + kstep, voffA); PG8_STAGE(PG8_SB(1, 1), cB + hstep + kstep, voffB);
        PG8_WAIT_V(6); PG8_BAR;
    } else {
        PG8_STAGE(PG8_SB(0, 0), cB, voffB); PG8_STAGE(PG8_SA(0, 0), cA, voffA); PG8_STAGE(PG8_SB(0, 1), cB + hstep, voffB); PG8_STAGE(PG8_SA(0, 1), cA + hstep, voffA);
        if (wr == 1) PG8_BAR;
        PG8_WAIT_V(4); PG8_BAR;
        PG8_STAGE(PG8_SB(1, 0), cB + kstep, voffB); PG8_STAGE(PG8_SA(1, 0), cA + kstep, voffA); PG8_STAGE(PG8_SB(1, 1), cB + hstep + kstep, voffB);
        PG8_WAIT_V(6); PG8_BAR;
    }
    for (;;) {
        const bool has_next = S.next(ui + 1, nxt);
        const char* nA = has_next ? (const char*)g.A + (size_t)nxt.pm * tstep : cA; const char* nB = has_next ? (const char*)g.Bt + (size_t)nxt.pn * tstep : cB;
        for (int t = 0; t < nt; t += 2) {
            const bool last = (t == nt - 2);
            const char* a1 = cA + (size_t)(t + 1) * kstep;
            const char* a2 = last ? nA : cA + (size_t)(t + 2) * kstep; const char* b2 = last ? nB : cB + (size_t)(t + 2) * kstep;
            const char* a3 = a2 + kstep; const char* b3 = b2 + kstep;
            if (last && has_next) S.a_ready(nxt);
            if constexpr (SP2) {
            PG8_LDB(B0, 0, 0); PG8_LDB(B1, 0, 1); PG8_SCHED; PG8_LDA(At, 0, 0); PG8_STAGE(PG8_SA(1, 1), a1 + hstep, voffA);
            PG8_WAIT_V(8); PG8_WAIT_L(0); PG8_BAR; PG8_MMA(0, 0, At, B0); PG8_MMA(0, 1, At, B1); PG8_BAR; PG8_SCHED;
            PG8_LDA(At, 0, 1); PG8_STAGE(PG8_SB(0, 0), b2, voffB); PG8_STAGE(PG8_SB(0, 1), b2 + hstep, voffB); PG8_STAGE(PG8_SA(0, 0), a2, voffA);
            PG8_WAIT_V(8); PG8_WAIT_L(0); PG8_BAR; PG8_MMA(1, 0, At, B0); PG8_MMA(1, 1, At, B1); PG8_BAR; PG8_SCHED;
            PG8_LDB(B0, 1, 0); PG8_LDB(B1, 1, 1); PG8_SCHED; PG8_LDA(At, 1, 0); PG8_STAGE(PG8_SA(0, 1), a2 + hstep, voffA);
            PG8_WAIT_V(8); PG8_WAIT_L(0); PG8_BAR; PG8_MMA(0, 0, At, B0); PG8_MMA(0, 1, At, B1); PG8_BAR; PG8_SCHED;
            PG8_LDA(At, 1, 1); PG8_STAGE(PG8_SB(1, 0), b3, voffB); PG8_STAGE(PG8_SB(1, 1), b3 + hstep, voffB); PG8_STAGE(PG8_SA(1, 0), a3, voffA);
            PG8_WAIT_V(8); PG8_WAIT_L(0); PG8_BAR; PG8_MMA(1, 0, At, B0); PG8_MMA(1, 1, At, B1); PG8_BAR; PG8_SCHED;
            } else {
            PG8_LDB(B0, 0, 0); PG8_SCHED; PG8_LDA(At, 0, 0); PG8_STAGE(PG8_SA(1, 1), a1 + hstep, voffA);
            PG8_WAIT_L(8); PG8_BAR; PG8_WAIT_L(0); PG8_MMA(0, 0, At, B0); PG8_BAR; PG8_SCHED;
            PG8_LDB(B1, 0, 1); PG8_STAGE(PG8_SB(0, 0), b2, voffB);
            PG8_BAR; PG8_WAIT_L(0); PG8_MMA(0, 1, At, B1); PG8_BAR;
            PG8_LDA(At, 0, 1); PG8_STAGE(PG8_SA(0, 0), a2, voffA);
            PG8_BAR; PG8_WAIT_L(0); PG8_MMA(1, 0, At, B0); PG8_BAR; PG8_SCHED;
            PG8_STAGE(PG8_SB(0, 1), b2 + hstep, voffB);
            PG8_WAIT_V(6); PG8_BAR; PG8_MMA(1, 1, At, B1); PG8_BAR;
            PG8_LDB(B0, 1, 0); PG8_SCHED; PG8_LDA(At, 1, 0); PG8_STAGE(PG8_SA(0, 1), a2 + hstep, voffA);
            PG8_WAIT_L(8); PG8_BAR; PG8_WAIT_L(0); PG8_MMA(0, 0, At, B0); PG8_BAR; PG8_SCHED;
            PG8_LDB(B1, 1, 1); PG8_STAGE(PG8_SB(1, 0), b3, voffB);
            PG8_BAR; PG8_WAIT_L(0); PG8_MMA(0, 1, At, B1); PG8_BAR;
            PG8_LDA(At, 1, 1); PG8_STAGE(PG8_SA(1, 0), a3, voffA);
            PG8_BAR; PG8_WAIT_L(0); PG8_MMA(1, 0, At, B0); PG8_BAR; PG8_SCHED;
            PG8_STAGE(PG8_SB(1, 1), b3 + hstep, voffB);
            PG8_WAIT_V(6); PG8_BAR; PG8_MMA(1, 1, At, B1); PG8_BAR;
            }
        }
        if constexpr (ALIGN_EPI) { if (wr == 0) PG8_BAR; }
        if constexpr (!Epi::AFTER_DRAIN) { E(acc, cur, wr, wc, fr, fq); S.done(cur); }
        if (!has_next) break;
#pragma unroll
        for (int a = 0; a < 2; ++a)
#pragma unroll
            for (int b = 0; b < 2; ++b)
#pragma unroll
                for (int m = 0; m < 4; ++m)
#pragma unroll
                    for (int n = 0; n < 2; ++n) acc[a][b][m][n] = (f32x4){0.f, 0.f, 0.f, 0.f};
        cur = nxt; cA = nA; cB = nB; ++ui;
        if constexpr (ALIGN_EPI) { if (wr == 1) PG8_BAR; }
    }
    PG8_WAIT_V(0);
    if constexpr (!ALIGN_EPI) { if (wr == 0) PG8_BAR; }
    PG8_BAR;
    if constexpr (Epi::AFTER_DRAIN) { E.fused(acc, cur, wr, wc, fr, fq, lds, wid, lane); S.done(cur); }
#undef PG8_SA
#undef PG8_SB
#undef PG8_STAGE
#undef PG8_LDA
#undef PG8_LDB
#undef PG8_MMA
#undef PG8_WAIT_V
#undef PG8_WAIT_L
#undef PG8_BAR
#undef PG8_SCHED
}
}
#endif
#ifndef EMU_HOST
#define SCHED_FENCE() __builtin_amdgcn_sched_barrier(0)
#define OPAQUE(v) asm volatile("" : "+v"(v))
#define UNIFORM(x) __builtin_amdgcn_readfirstlane(x)
#else
#define SCHED_FENCE() do {} while (0)
#define OPAQUE(v) do {} while (0)
#define UNIFORM(x) (x)
#endif
constexpr int HG_QM = 0, HG_KM = 17408, HG_KMT = 34816, HG_VT = 53248, HG_A = 71680, HG_VEC = 80896, HG_GSUM = 82432, HG_OSQ = 86528, HG_END = 88576;
static_assert(HG_END <= RING_BYTES, "HGRN LDS");

template <bool FULL>
DEV void hgrn_unit(LAS unsigned char* lds, int tid, const bf16_t* zq, const bf16_t* zg, const bf16_t* zv, const bf16_t* zgate, const float* gout, bf16_t* ob,
                   int rowbase, int nchunks, int h, const float* s_init, float* s_out, float* gseg_out) {
    OPAQUE(tid);
    const int lane = tid & 63, w = UNIFORM(tid >> 6), l16 = lane & 15, q4 = lane >> 4, kp = tid & 63, tg = w;
    f32x4 S[8];
#pragma unroll
    for (int kb = 0; kb < 8; ++kb)
#pragma unroll
        for (int r = 0; r < 4; ++r) S[kb][r] = s_init ? s_init[(size_t)(16 * kb + 4 * q4 + r) * HD + 16 * w + l16] : 0.f;
    unsigned pq[8], pg[8], pv[8];
    const size_t colq = (size_t)h * HD + 2 * kp;
#pragma unroll
    for (int i = 0; i < 8; ++i) { const size_t o = (size_t)(rowbase + 8 * tg + i) * D + colq; pg[i] = *(const unsigned*)(zg + o); pv[i] = *(const unsigned*)(zv + o); if (FULL) pq[i] = *(const unsigned*)(zq + o); }
    float gs0 = 0.f, gs1 = 0.f;
    for (int c = 0; c < nchunks; ++c) {
        float G0[8], G1[8], g0[8], g1[8];
        { float c0 = 0.f, c1 = 0.f;
#pragma unroll
          for (int i = 0; i < 8; ++i) { g0[i] = h_lo(pg[i]); g1[i] = h_hi(pg[i]); c0 += g0[i]; c1 += g1[i]; G0[i] = c0; G1[i] = c1; }
          *(LAS f32x2*)(lds + HG_GSUM + (tg * 128 + 2 * kp) * 4) = (f32x2){c0, c1}; }
        BLOCK_SYNC();
        float P0 = 0.f, P1 = 0.f, T0 = 0.f, T1 = 0.f, M0 = 0.f, M1 = 0.f;
#pragma unroll
        for (int j = 0; j < 8; ++j) { const f32x2 s = *(const LAS f32x2*)(lds + HG_GSUM + (j * 128 + 2 * kp) * 4); if (j < tg) { P0 += s.x; P1 += s.y; } if (j < 4) { M0 += s.x; M1 += s.y; } T0 += s.x; T1 += s.y; }
        unsigned kmw[8];
#pragma unroll
        for (int i = 0; i < 8; ++i) { const int t = 8 * tg + i; const float Gt0 = P0 + G0[i], Gt1 = P1 + G1[i];
            const float ek0 = fexp(fminf(M0 - Gt0, 80.f)), ek1 = fexp(fminf(M1 - Gt1, 80.f));
            kmw[i] = pk2((1.f - fexp(g0[i])) * ek0, (1.f - fexp(g1[i])) * ek1);
            if (FULL) { const float eq0 = fexp(fminf(Gt0 - M0, 80.f)), eq1 = fexp(fminf(Gt1 - M1, 80.f));
                *(LAS unsigned*)(lds + HG_QM + t * 272 + 4 * kp) = pk2(bf_lo(pq[i]) * eq0, bf_hi(pq[i]) * eq1);
                *(LAS unsigned*)(lds + HG_KM + t * 272 + 4 * kp) = kmw[i]; } }
        { u32x4 a, b;
          a.x = (kmw[0] & 0xffffu) | (kmw[1] << 16); a.y = (kmw[2] & 0xffffu) | (kmw[3] << 16); a.z = (kmw[4] & 0xffffu) | (kmw[5] << 16); a.w = (kmw[6] & 0xffffu) | (kmw[7] << 16);
          b.x = (kmw[0] >> 16) | (kmw[1] & 0xffff0000u); b.y = (kmw[2] >> 16) | (kmw[3] & 0xffff0000u); b.z = (kmw[4] >> 16) | (kmw[5] & 0xffff0000u); b.w = (kmw[6] >> 16) | (kmw[7] & 0xffff0000u);
          *(LAS u32x4*)(lds + HG_KMT + (2 * kp) * 144 + tg * 16) = a; *(LAS u32x4*)(lds + HG_KMT + (2 * kp + 1) * 144 + tg * 16) = b;
          a.x = (pv[0] & 0xffffu) | (pv[1] << 16); a.y = (pv[2] & 0xffffu) | (pv[3] << 16); a.z = (pv[4] & 0xffffu) | (pv[5] << 16); a.w = (pv[6] & 0xffffu) | (pv[7] << 16);
          b.x = (pv[0] >> 16) | (pv[1] & 0xffff0000u); b.y = (pv[2] >> 16) | (pv[3] & 0xffff0000u); b.z = (pv[4] >> 16) | (pv[5] & 0xffff0000u); b.w = (pv[6] >> 16) | (pv[7] & 0xffff0000u);
          *(LAS u32x4*)(lds + HG_VT + (2 * kp) * 144 + tg * 16) = a; *(LAS u32x4*)(lds + HG_VT + (2 * kp + 1) * 144 + tg * 16) = b; }
        if (tg == 0) { LAS float* vec = (LAS float*)(lds + HG_VEC);
            *(LAS f32x2*)(vec + 2 * kp) = (f32x2){fexp(M0), fexp(M1)}; *(LAS f32x2*)(vec + 128 + 2 * kp) = (f32x2){fexp(T0), fexp(T1)}; *(LAS f32x2*)(vec + 256 + 2 * kp) = (f32x2){fexp(T0 - M0), fexp(T1 - M1)};
            gs0 += T0; gs1 += T1; }
        if (c + 1 < nchunks) {
#pragma unroll
            for (int i = 0; i < 8; ++i) { const size_t o = (size_t)(rowbase + (c + 1) * CH + 8 * tg + i) * D + colq; pg[i] = *(const unsigned*)(zg + o); pv[i] = *(const unsigned*)(zv + o); if (FULL) pq[i] = *(const unsigned*)(zq + o); } }
        BLOCK_SYNC();
        if (FULL) { const int tb = w & 3;
#pragma unroll
            for (int sbi = 0; sbi < 2; ++sbi) { const int sb = 2 * (w >> 2) + sbi;
                if (sb <= tb) { f32x4 acc = {0.f, 0.f, 0.f, 0.f};
#pragma unroll
                    for (int st = 0; st < 4; ++st) { const bf16x8 a = *(const LAS bf16x8*)(lds + HG_KM + (16 * sb + l16) * 272 + (32 * st + 8 * q4) * 2), b = *(const LAS bf16x8*)(lds + HG_QM + (16 * tb + l16) * 272 + (32 * st + 8 * q4) * 2);
                        acc = MFMA16(a, b, acc); }
                    if (sb == tb) {
#pragma unroll
                        for (int r = 0; r < 4; ++r) if (4 * q4 + r > l16) acc[r] = 0.f; }
                    *(LAS u32x2*)(lds + HG_A + (16 * tb + l16) * 144 + (16 * sb + 4 * q4) * 2) = (u32x2){pk2(acc[0], acc[1]), pk2(acc[2], acc[3])};
                } else if ((sb >> 1) <= (tb >> 1)) *(LAS u32x2*)(lds + HG_A + (16 * tb + l16) * 144 + (16 * sb + 4 * q4) * 2) = (u32x2){0u, 0u};
            }
            BLOCK_SYNC(); }
        const LAS float* vec = (const LAS float*)(lds + HG_VEC);
        bf16x8 vtf[2];
#pragma unroll
        for (int ss = 0; ss < 2; ++ss) vtf[ss] = *(const LAS bf16x8*)(lds + HG_VT + (16 * w + l16) * 144 + (32 * ss + 8 * q4) * 2);
        f32x4 o[4];
        if (FULL) {
            bf16x8 bfr[4];
#pragma unroll
            for (int j = 0; j < 4; ++j) { const f32x4 e0 = *(const LAS f32x4*)(vec + 32 * j + 4 * q4), e1 = *(const LAS f32x4*)(vec + 32 * j + 16 + 4 * q4);
                u32x4 t; t.x = pk2(S[2 * j][0] * e0[0], S[2 * j][1] * e0[1]); t.y = pk2(S[2 * j][2] * e0[2], S[2 * j][3] * e0[3]); t.z = pk2(S[2 * j + 1][0] * e1[0], S[2 * j + 1][1] * e1[1]); t.w = pk2(S[2 * j + 1][2] * e1[2], S[2 * j + 1][3] * e1[3]);
                bfr[j] = __builtin_bit_cast(bf16x8, t); }
#pragma unroll
            for (int tb = 0; tb < 4; ++tb) { f32x4 acc = {0.f, 0.f, 0.f, 0.f};
#pragma unroll
                for (int j = 0; j < 4; ++j) { const u32x2 a0 = *(const LAS u32x2*)(lds + HG_QM + (16 * tb + l16) * 272 + (32 * j + 4 * q4) * 2), a1 = *(const LAS u32x2*)(lds + HG_QM + (16 * tb + l16) * 272 + (32 * j + 16 + 4 * q4) * 2);
                    const u32x4 t = {a0.x, a0.y, a1.x, a1.y}; acc = MFMA16(__builtin_bit_cast(bf16x8, t), bfr[j], acc); }
#pragma unroll
                for (int ss = 0; ss < 2; ++ss) if (ss == 0 || tb >= 2) { const bf16x8 a = *(const LAS bf16x8*)(lds + HG_A + (16 * tb + l16) * 144 + (32 * ss + 8 * q4) * 2); acc = MFMA16(a, vtf[ss], acc); }
                o[tb] = acc; SCHED_FENCE(); }
        }
#pragma unroll
        for (int kb = 0; kb < 8; ++kb) { f32x4 u = {0.f, 0.f, 0.f, 0.f};
#pragma unroll
            for (int ss = 0; ss < 2; ++ss) { const bf16x8 a = *(const LAS bf16x8*)(lds + HG_KMT + (16 * kb + l16) * 144 + (32 * ss + 8 * q4) * 2); u = MFMA16(a, vtf[ss], u); }
            const f32x4 av = *(const LAS f32x4*)(vec + 128 + 16 * kb + 4 * q4), bv = *(const LAS f32x4*)(vec + 256 + 16 * kb + 4 * q4);
#pragma unroll
            for (int r = 0; r < 4; ++r) S[kb][r] = av[r] * S[kb][r] + bv[r] * u[r]; SCHED_FENCE(); }
        if (FULL) {
#pragma unroll
            for (int tb = 0; tb < 4; ++tb)
#pragma unroll
                for (int r = 0; r < 4; ++r) { float sq = o[tb][r] * o[tb][r]; sq += SHFL_XOR(sq, 1); sq += SHFL_XOR(sq, 2); sq += SHFL_XOR(sq, 4); sq += SHFL_XOR(sq, 8);
                    if (l16 == 0) *(LAS float*)(lds + HG_OSQ + ((16 * tb + 4 * q4 + r) * 8 + w) * 4) = sq; }
            BLOCK_SYNC();
            const int col = h * HD + 16 * w + l16; const float gv = gout[col];
#pragma unroll
            for (int tb = 0; tb < 4; ++tb)
#pragma unroll
                for (int r = 0; r < 4; ++r) { const int t = 16 * tb + 4 * q4 + r; const f32x4 s0 = *(const LAS f32x4*)(lds + HG_OSQ + t * 32), s1 = *(const LAS f32x4*)(lds + HG_OSQ + t * 32 + 16);
                    const float tot = ((s0[0] + s0[1]) + (s0[2] + s0[3])) + ((s1[0] + s1[1]) + (s1[2] + s1[3])); const float rstd = frsq(tot * (1.0f / HD) + EPS);
                    const size_t oo = (size_t)(rowbase + c * CH + t) * D + col;
                    ob[oo] = (bf16_t)(pk2(o[tb][r] * rstd * gv * bf2f(zgate[oo]), 0.f) & 0xffffu); }
        }
    }
    if (s_out) {
#pragma unroll
        for (int kb = 0; kb < 8; ++kb)
#pragma unroll
            for (int r = 0; r < 4; ++r) s_out[(size_t)(16 * kb + 4 * q4 + r) * HD + 16 * w + l16] = S[kb][r]; }
    if (gseg_out && tg == 0) { gseg_out[2 * kp] = gs0; gseg_out[2 * kp + 1] = gs1; }
    BLOCK_SYNC();
}

DEV void hgrn_scan(int gtid, int GT, const float* lseg, const float* gseg, float* sstart) {
    OPAQUE(gtid);
    for (int e = gtid; e < 32 * HD * HD; e += GT) { const int stream = e >> 14, kv = e & 16383, k = kv >> 7; float s = 0.f;
        for (int j = 0; j < NSEG - 1; ++j) { const size_t sj = (size_t)stream * NSEG + j; s = fexp(gseg[sj * HD + k]) * s + lseg[(sj << 14) + kv]; sstart[((sj + 1) << 14) + kv] = s; } }
}

template <int PT>
DEV void cumsum_unit(LAS unsigned char* lds, int tid, const float* a, int na, int sa, const float* b, int sb, int n, float* dst) {
    OPAQUE(tid);
    LAS double* part = (LAS double*)lds; LAS double* grp = part + 512;
    float v[PT]; double loc = 0.0;
#pragma unroll
    for (int i = 0; i < PT; ++i) { const int p = tid * PT + i; v[i] = p < n ? (p < na ? a[(size_t)p * sa] : b[(size_t)(p - na) * sb]) : 0.f; loc += (double)v[i]; }
    part[tid] = loc;
    BLOCK_SYNC();
    double pre = 0.0; const int g0 = tid & ~15;
    for (int j = g0; j < tid; ++j) pre += part[j];
    if ((tid & 15) == 15) grp[tid >> 4] = pre + loc;
    BLOCK_SYNC();
    for (int j = 0; j < (tid >> 4); ++j) pre += grp[j];
#pragma unroll
    for (int i = 0; i < PT; ++i) { const int p = tid * PT + i; pre += (double)v[i]; if (p < n) dst[p] = (float)pre; }
    BLOCK_SYNC();
}

constexpr int AT_K = 0, AT_VT = 17408, AT_DK = 35840, AT_END = 36096;
DEV void attn_block(LAS unsigned char* lds, int tid, const bf16_t* Q, const bf16_t* gate, bf16_t* O, const bf16_t* Kb, const bf16_t* Vb, const float* Dc, int qpos0, int nrows) {
    OPAQUE(tid);
    const int lane = tid & 63, w = UNIFORM(tid >> 6), l16 = lane & 15, q4 = lane >> 4, dp = tid & 63, kg = w;
    const bool active = 32 * w < nrows;
    const int ntiles = (qpos0 + nrows + 63) >> 6;
    constexpr float C2 = 0.08838834764831845f * LOG2E;
    bf16x8 Qf[2][4]; float Dq2[2], mrun[2], lrun[2]; f32x4 Oa[2][8];
#pragma unroll
    for (int qb = 0; qb < 2; ++qb) { const int r = active ? 32 * w + 16 * qb + l16 : 0;
#pragma unroll
        for (int st = 0; st < 4; ++st) Qf[qb][st] = *(const bf16x8*)(Q + (size_t)r * D + 32 * st + 8 * q4);
        Dq2[qb] = Dc[qpos0 + r] * LOG2E; mrun[qb] = -1e30f; lrun[qb] = 0.f;
#pragma unroll
        for (int db = 0; db < 8; ++db) Oa[qb][db] = (f32x4){0.f, 0.f, 0.f, 0.f}; }
    u32x4 pk_[2]; unsigned pv[8]; float pd = 0.f;
    const int krow = tid >> 4, kc16 = tid & 15;
#define AT_LOAD(j) do { _Pragma("unroll") for (int i = 0; i < 2; ++i) pk_[i] = *(const u32x4*)(Kb + (size_t)(64 * (j) + krow + 32 * i) * D + kc16 * 8); \
        _Pragma("unroll") for (int i = 0; i < 8; ++i) pv[i] = *(const unsigned*)(Vb + (size_t)(64 * (j) + 8 * kg + i) * D + 2 * dp); \
        if (tid < 64) pd = Dc[64 * (j) + tid] * LOG2E; } while (0)
    AT_LOAD(0);
    const int ks_ = kg >> 2, kq = kg & 3, hb = kq >> 1;
    const int vpos0 = (32 * ks_ + 16 * (kq & 1) + 4 * hb) * 2, vpos1 = vpos0 + 16;
    for (int j = 0; j < ntiles; ++j) {
        BLOCK_SYNC();
#pragma unroll
        for (int i = 0; i < 2; ++i) *(LAS u32x4*)(lds + AT_K + (krow + 32 * i) * 272 + kc16 * 16) = pk_[i];
        { u32x2 a, b;
          a.x = (pv[0] & 0xffffu) | (pv[1] << 16); a.y = (pv[2] & 0xffffu) | (pv[3] << 16); b.x = (pv[4] & 0xffffu) | (pv[5] << 16); b.y = (pv[6] & 0xffffu) | (pv[7] << 16);
          *(LAS u32x2*)(lds + AT_VT + (2 * dp) * 144 + vpos0) = a; *(LAS u32x2*)(lds + AT_VT + (2 * dp) * 144 + vpos1) = b;
          a.x = (pv[0] >> 16) | (pv[1] & 0xffff0000u); a.y = (pv[2] >> 16) | (pv[3] & 0xffff0000u); b.x = (pv[4] >> 16) | (pv[5] & 0xffff0000u); b.y = (pv[6] >> 16) | (pv[7] & 0xffff0000u);
          *(LAS u32x2*)(lds + AT_VT + (2 * dp + 1) * 144 + vpos0) = a; *(LAS u32x2*)(lds + AT_VT + (2 * dp + 1) * 144 + vpos1) = b; }
        if (tid < 64) *(LAS float*)(lds + AT_DK + tid * 4) = pd;
        BLOCK_SYNC();
        if (j + 1 < ntiles) AT_LOAD(j + 1);
        if (active && 64 * j <= qpos0 + 32 * w + 31) {
            f32x4 s[2][4];
#pragma unroll
            for (int kb = 0; kb < 4; ++kb) { bf16x8 kf[4];
#pragma unroll
                for (int st = 0; st < 4; ++st) kf[st] = *(const LAS bf16x8*)(lds + AT_K + (16 * kb + l16) * 272 + (32 * st + 8 * q4) * 2);
#pragma unroll
                for (int qb = 0; qb < 2; ++qb) { f32x4 acc = {0.f, 0.f, 0.f, 0.f};
#pragma unroll
                    for (int st = 0; st < 4; ++st) acc = MFMA16(kf[st], Qf[qb][st], acc);
                    s[qb][kb] = acc; } SCHED_FENCE(); }
            const bool need_mask = 64 * j + 63 > qpos0 + 32 * w;
#pragma unroll
            for (int qb = 0; qb < 2; ++qb) { const int qpos = qpos0 + 32 * w + 16 * qb + l16; float mx = -__builtin_inff();
#pragma unroll
                for (int kb = 0; kb < 4; ++kb) { const f32x4 dk = *(const LAS f32x4*)(lds + AT_DK + (16 * kb + 4 * q4) * 4);
#pragma unroll
                    for (int r = 0; r < 4; ++r) { float v = s[qb][kb][r] * C2 + (Dq2[qb] - dk[r]); if (need_mask && 64 * j + 16 * kb + 4 * q4 + r > qpos) v = -__builtin_inff(); s[qb][kb][r] = v; mx = fmaxf(mx, v); } }
                mx = fmaxf(mx, SHFL_XOR(mx, 16)); mx = fmaxf(mx, SHFL_XOR(mx, 32));
                const float mn = fmaxf(mrun[qb], mx), alpha = fexp2(mrun[qb] - mn); mrun[qb] = mn; float ps = 0.f;
#pragma unroll
                for (int kb = 0; kb < 4; ++kb)
#pragma unroll
                    for (int r = 0; r < 4; ++r) { const float p = fexp2(s[qb][kb][r] - mn); s[qb][kb][r] = p; ps += p; }
                lrun[qb] = lrun[qb] * alpha + ps;
#pragma unroll
                for (int db = 0; db < 8; ++db) Oa[qb][db] = Oa[qb][db] * alpha; }
            bf16x8 pf[2][2];
#pragma unroll
            for (int qb = 0; qb < 2; ++qb)
#pragma unroll
                for (int ks = 0; ks < 2; ++ks) { u32x4 t; t.x = pk2(s[qb][2 * ks][0], s[qb][2 * ks][1]); t.y = pk2(s[qb][2 * ks][2], s[qb][2 * ks][3]); t.z = pk2(s[qb][2 * ks + 1][0], s[qb][2 * ks + 1][1]); t.w = pk2(s[qb][2 * ks + 1][2], s[qb][2 * ks + 1][3]);
                    pf[qb][ks] = __builtin_bit_cast(bf16x8, t); }
#pragma unroll
            for (int db = 0; db < 8; ++db)
#pragma unroll
                for (int ks = 0; ks < 2; ++ks) { const bf16x8 a = *(const LAS bf16x8*)(lds + AT_VT + (16 * db + l16) * 144 + (32 * ks + 8 * q4) * 2);
#pragma unroll
                    for (int qb = 0; qb < 2; ++qb) Oa[qb][db] = MFMA16(a, pf[qb][ks], Oa[qb][db]); if (ks == 1) SCHED_FENCE(); }
        }
    }
#undef AT_LOAD
    if (active) {
#pragma unroll
        for (int qb = 0; qb < 2; ++qb) { float l = lrun[qb]; l += SHFL_XOR(l, 16); l += SHFL_XOR(l, 32); const float inv = 1.0f / l; const size_t ro = (size_t)(32 * w + 16 * qb + l16) * D;
#pragma unroll
            for (int db = 0; db < 8; ++db) { const u32x2 gt = *(const u32x2*)(gate + ro + 16 * db + 4 * q4); const f32x4 ov = Oa[qb][db] * inv;
                *(u32x2*)(O + ro + 16 * db + 4 * q4) = (u32x2){pk2(ov[0] * bf_lo(gt.x), ov[1] * bf_hi(gt.x)), pk2(ov[2] * bf_lo(gt.y), ov[3] * bf_hi(gt.y))}; } }
    }
    BLOCK_SYNC();
}
#ifndef EMU_HOST
#define RLX_AGENT __ATOMIC_RELAXED, __HIP_MEMORY_SCOPE_AGENT
#define LDS_WAIT() asm volatile("s_waitcnt lgkmcnt(0)" ::: "memory")
typedef GAS unsigned gu32;
#define XB_TMO      128
#define XB_XCNT(j)  (256  + 64 * (j))
#define XB_XSUB(j)  (1280 + 64 * (j))
#define XB_XGEN(j)  (2304 + 64 * (j))
#define XB_TOP      3328
#define XB_TOPGEN   3392
#define XCD_BAR_WORDS 3456
#define XB_SPIN_CAP (1u << 18)

__device__ __forceinline__ unsigned xb_ld(unsigned* p)              { return __hip_atomic_load(p, __ATOMIC_RELAXED, __HIP_MEMORY_SCOPE_AGENT); }
__device__ __forceinline__ unsigned xb_add(unsigned* p, unsigned v) { return __hip_atomic_fetch_add(p, v, __ATOMIC_RELAXED, __HIP_MEMORY_SCOPE_AGENT); }
__device__ __forceinline__ unsigned xb_xcc_id() { return (unsigned)__builtin_amdgcn_s_getreg((3 << 11) | 20) & 0xFu; }
#define XB_SPIN(cond, bar) do { unsigned _sp = 0; while (cond) { __builtin_amdgcn_s_sleep(1); \
    if ((++_sp & 255u) == 0u) { if (xb_ld(&(bar)[XB_TMO])) break; if (_sp > XB_SPIN_CAP) { atomicAdd(&(bar)[XB_TMO], 1u); break; } } } } while (0)

struct XcdBarrier {
    unsigned* bar; unsigned x;
    volatile LAS unsigned* st;
};

__device__ __forceinline__ XcdBarrier xcd_barrier_post(unsigned* bar, volatile LAS unsigned* st) {
    XcdBarrier b; b.bar = bar; b.x = xb_xcc_id(); b.st = st;
    if (threadIdx.x == 0) (void)xb_add(&bar[XB_XCNT(b.x)], 1u);
    return b;
}
__device__ __forceinline__ void xcd_barrier_complete(unsigned* bar, unsigned x, unsigned& nloc, unsigned& nx) {
    const unsigned G = gridDim.x * gridDim.y * gridDim.z;
    unsigned sum, cnt, mine, sp = 0u;
    for (;;) {
        sum = 0u; cnt = 0u; mine = 0u;
#pragma unroll
        for (unsigned j = 0; j < 16; ++j) { const unsigned c = xb_ld(&bar[XB_XCNT(j)]); sum += c; cnt += (c > 0u) ? 1u : 0u; mine = (j == x) ? c : mine; }
        if (sum == G) break;
        __builtin_amdgcn_s_sleep(1);
        if ((++sp & 255u) == 0u) { if (xb_ld(&bar[XB_TMO])) break; if (sp > XB_SPIN_CAP) { atomicAdd(&bar[XB_TMO], 1u); break; } }
    }
    nloc = mine > 0u ? mine : 1u; nx = cnt > 0u ? cnt : 1u;
}

__device__ __forceinline__ void xcd_barrier(const XcdBarrier& b) {
    asm volatile("s_waitcnt vmcnt(0)" ::: "memory");
    __syncthreads();
    if (threadIdx.x == 0) {
        unsigned* bar = b.bar;
        __builtin_amdgcn_s_waitcnt(0);
        unsigned nloc = b.st[0], nx = b.st[1];
        if (nloc == 0u) { xcd_barrier_complete(bar, b.x, nloc, nx); b.st[0] = nloc; b.st[1] = nx; }
        const unsigned old = xb_add(&bar[XB_XSUB(b.x)], 1u);
        const unsigned gen = old / nloc;
        if (old + 1u == (gen + 1u) * nloc) {
            __builtin_amdgcn_fence(__ATOMIC_RELEASE, "agent");
            asm volatile("s_waitcnt vmcnt(0)" ::: "memory");
            const unsigned og = xb_add(&bar[XB_TOP], 1u);
            const unsigned tg = og / nx;
            if (og + 1u == (tg + 1u) * nx) xb_add(&bar[XB_TOPGEN], 1u);
            else XB_SPIN(xb_ld(&bar[XB_TOPGEN]) == tg, bar);
            __builtin_amdgcn_fence(__ATOMIC_ACQUIRE, "agent");
            xb_add(&bar[XB_XGEN(b.x)], 1u);
            asm volatile("s_waitcnt vmcnt(0)" ::: "memory");
        } else {
            XB_SPIN(xb_ld(&bar[XB_XGEN(b.x)]) == gen, bar);
            __builtin_amdgcn_fence(__ATOMIC_ACQUIRE, "agent");
            asm volatile("s_waitcnt vmcnt(0)" ::: "memory");
        }
    }
    __syncthreads();
}


__device__ __forceinline__ void p0_transpose_item(const float* W, int K, int N, int pitch, const float* gain, bf16_t* WT, int row_off, LAS float* scr, int item, int lane) {
    const int nblk = N / 32, kb = item / nblk, nb = item % nblk, k0 = 64 * kb, n0 = 32 * nb;
#pragma unroll 8
    for (int i = 0; i < 32; ++i) { const int kk = 2 * i + (lane >> 5); const float gk = gain ? gain[k0 + kk] : 1.0f; scr[kk * 33 + (lane & 31)] = W[(size_t)(k0 + kk) * pitch + n0 + (lane & 31)] * gk; }
    LDS_WAIT(); asm volatile("" ::: "memory");
    const int c = lane & 7;
#pragma unroll
    for (int j = 0; j < 4; ++j) { const int n = (lane >> 3) + 8 * j; const LAS float* s = scr + (8 * c) * 33 + n;
        u32x4 o; o.x = pk2(s[0 * 33], s[1 * 33]); o.y = pk2(s[2 * 33], s[3 * 33]); o.z = pk2(s[4 * 33], s[5 * 33]); o.w = pk2(s[6 * 33], s[7 * 33]);
        *(u32x4*)(WT + (size_t)(row_off + n0 + n) * K + k0 + 8 * c) = o; }
    LDS_WAIT(); asm volatile("" ::: "memory");
}
__device__ __forceinline__ float wave_sum(float v) {
#pragma unroll
    for (int o = 1; o < 64; o <<= 1) v += __shfl_xor(v, o);
    return v;
}

#ifndef SITES
#define SITES 0xFFFF
#endif
#define SITE(k) ((SITES >> (k)) & 1)
struct Args { const float* in[23]; float* out; unsigned char* ws; int ph_lo, ph_hi; };
constexpr int N_PHASES = 26;
__host__ __device__ constexpr bool phase_nonempty(int p) { return !(p == 15 || p == 20 || p == 21); }

__global__ void __launch_bounds__(NWAVES * 64, 2) fwd(Args args) {
    extern __shared__ __attribute__((aligned(16))) unsigned char lds_raw[];
    LAS unsigned char* lds = (LAS unsigned char*)lds_raw;
    volatile LAS unsigned* MISC = (volatile LAS unsigned*)(lds + MISC_OFF);
    const int G = gridDim.x, bx = blockIdx.x, vcu = (G % 8 == 0) ? (bx % 8) * (G / 8) + bx / 8 : bx;
    gu32* ctl = (gu32*)(args.ws + WS_CTL);
    for (int u = threadIdx.x; u < (LDS_BYTES - LDSCTL_OFF) / 4; u += NWAVES * 64) ((LAS unsigned*)(lds + LDSCTL_OFF))[u] = 0u;
    __syncthreads();
    const bool one_launch = (args.ph_lo == 0 && args.ph_hi == N_PHASES);
    XcdBarrier bar; bar.bar = (unsigned*)(ctl + CW_BAR); bar.x = 0; bar.st = nullptr;
    if (one_launch) bar = xcd_barrier_post((unsigned*)(ctl + CW_BAR), MISC + 8);
    const int lo = args.ph_lo, hi = args.ph_hi;
#define IN(k) (lo <= (k) && (k) < hi)
#define SEAM(k) do { if ((k) + 1 < hi) xcd_barrier(bar); } while (0)
#define SITE_FRAME() int tid = threadIdx.x; asm volatile("" : "+v"(tid)); GAS unsigned char* wsb = (GAS unsigned char*)args.ws; asm volatile("" : "+s"(wsb)); \
    const int lane = tid & 63, wave = __builtin_amdgcn_readfirstlane(tid >> 6), gw = vcu * NWAVES + wave, NGW = G * NWAVES, gtid = vcu * (NWAVES * 64) + tid, GT = G * NWAVES * 64; \
    (void)lane; (void)wave; (void)gw; (void)NGW; (void)gtid; (void)GT; (void)wsb
#define x_prompt (args.in[0])
#define x_sample (args.in[1])
#define state_hgrn (args.in[2])
#define cache_k (args.in[3])
#define cache_v (args.in[4])
#define cache_logf (args.in[5])
#define p_prompt (args.in[6])
#define p_sample (args.in[7])
#define g_norm_a (args.in[8])
#define w_in_a (args.in[9])
#define lb_logits (args.in[10])
#define g_out_a (args.in[11])
#define w_out_a (args.in[12])
#define g_kv (args.in[13])
#define w_kv (args.in[14])
#define b_f (args.in[15])
#define g_norm_b (args.in[16])
#define w_in_b (args.in[17])
#define w_out_b (args.in[18])
#define w_ple_in (args.in[19])
#define g_ple (args.in[20])
#define w_ple_gate (args.in[21])
#define g_final (args.in[22])
#define ss ((float*)(wsb + WS_SS))
#define lbv ((float*)(wsb + WS_LBV))
#define gseg ((float*)(wsb + WS_GSEG))
#define Dp ((float*)(wsb + WS_DP))
#define Ds ((float*)(wsb + WS_DS))
#define LF ((float*)(wsb + WS_LF))
#define W_AIN ((bf16_t*)(wsb + WS_WAIN))
#define W_AOUT ((bf16_t*)(wsb + WS_WAOUT))
#define W_KVQ ((bf16_t*)(wsb + WS_WKVQ))
#define W_BIN1 ((bf16_t*)(wsb + WS_WBIN1))
#define W_BOUT ((bf16_t*)(wsb + WS_WBOUT))
#define W_PIN ((bf16_t*)(wsb + WS_WPIN))
#define W_PG ((bf16_t*)(wsb + WS_WPG))
#define X ((float*)(wsb + WS_X))
#define XB ((bf16_t*)(wsb + WS_XB))
#define XB2 ((bf16_t*)(wsb + WS_XB2))
#define ZQ ((bf16_t*)(wsb + WS_ZQ))
#define ZG ((bf16_t*)(wsb + WS_ZG))
#define ZV ((bf16_t*)(wsb + WS_ZV))
#define ZGATE ((bf16_t*)(wsb + WS_ZGATE))
#define OB ((bf16_t*)(wsb + WS_OB))
#define EB ((bf16_t*)(wsb + WS_EB))
#define PB ((bf16_t*)(wsb + WS_PB))
#define KS ((bf16_t*)(wsb + WS_KS))
#define VS ((bf16_t*)(wsb + WS_VS))
#define KP ((bf16_t*)(wsb + WS_KP))
#define VP ((bf16_t*)(wsb + WS_VP))
#define LSEG ((float*)(wsb + WS_LSEG))
#define SSTART ((float*)(wsb + WS_SSTART))
#define out (args.out)
    if (SITE(10) && IN(0)) { SITE_FRAME();
        LAS float* scr = (LAS float*)(lds + wave * 16384);
        constexpr int I_AIN = 32 * 256, I_SQ = 32 * 64, I_KV = 32 * 128, I_PIN = 4 * 64;
        constexpr int NITEMS = 2 * I_AIN + 2 * I_SQ + 3 * I_KV + 2 * I_SQ + 4 * I_PIN + 4 * I_SQ;
        for (int it = gw; it < NITEMS; it += NGW) {
            int r = it;
            if (r < 2 * I_AIN) { const int l = r / I_AIN; p0_transpose_item(w_in_a + (size_t)l * D * 4 * D, D, 4 * D, 4 * D, g_norm_a + l * D, W_AIN + (size_t)l * 4 * D * D, 0, scr, r % I_AIN, lane); continue; } r -= 2 * I_AIN;
            if (r < 2 * I_SQ) { const int l = r / I_SQ; p0_transpose_item(w_out_a + (size_t)l * D * D, D, D, D, nullptr, W_AOUT + (size_t)l * D * D, 0, scr, r % I_SQ, lane); continue; } r -= 2 * I_SQ;
            if (r < I_KV) { p0_transpose_item(w_kv, D, 2 * D, 2 * D + H, g_kv, W_KVQ, 0, scr, r, lane); continue; } r -= I_KV;
            if (r < I_KV) { p0_transpose_item(w_in_b, D, 2 * D, 2 * D, g_norm_b, W_KVQ, 2 * D, scr, r, lane); continue; } r -= I_KV;
            if (r < I_KV) { p0_transpose_item(w_in_b + (size_t)D * 2 * D, D, 2 * D, 2 * D, g_norm_b + D, W_BIN1, 0, scr, r, lane); continue; } r -= I_KV;
            if (r < 2 * I_SQ) { const int l = r / I_SQ; p0_transpose_item(w_out_b + (size_t)l * D * D, D, D, D, nullptr, W_BOUT + (size_t)l * D * D, 0, scr, r % I_SQ, lane); continue; } r -= 2 * I_SQ;
            if (r < 4 * I_PIN) { const int l = r / I_PIN; p0_transpose_item(w_ple_in + (size_t)l * DPLE * D, DPLE, D, D, nullptr, W_PIN + (size_t)l * D * DPLE, 0, scr, r % I_PIN, lane); continue; } r -= 4 * I_PIN;
            { const int l = r / I_SQ; p0_transpose_item(w_ple_gate + (size_t)l * D * D, D, D, D, g_ple + l * D, W_PG + (size_t)l * D * D, 0, scr, r % I_SQ, lane); }
        }
        for (int e = gtid; e < 256 * D; e += GT) { const int n = e / D, k = e % D; W_KVQ[(size_t)(4 * D + n) * D + k] = n < H ? (bf16_t)(pk2(g_kv[k] * w_kv[(size_t)k * (2 * D + H) + 2 * D + n], 0.f) & 0xffffu) : (bf16_t)0; }
        for (int m = gw; m < M; m += NGW) { const float* xr = m < MP ? x_prompt + (size_t)m * D : x_sample + (size_t)(m - MP) * D; float s = 0.f;
#pragma unroll
            for (int j = 0; j < 8; ++j) { const f32x4 v = *(const f32x4*)(xr + 256 * j + 4 * lane); s += (v[0] * v[0] + v[1] * v[1]) + (v[2] * v[2] + v[3] * v[3]);
                *(u32x2*)(XB + (size_t)m * D + 256 * j + 4 * lane) = (u32x2){pk2(v[0], v[1]), pk2(v[2], v[3])}; }
            s = wave_sum(s); if (lane == 0) ss[m] = s; }
        for (size_t e = (size_t)gtid * 8; e < (size_t)4 * M * DPLE; e += (size_t)GT * 8) { const int l = (int)(e / ((size_t)M * DPLE)); const size_t r = e % ((size_t)M * DPLE); const int m = (int)(r / DPLE), c = (int)(r % DPLE);
            const float* src = m < MP ? p_prompt + ((size_t)l * MP + m) * DPLE + c : p_sample + ((size_t)l * MS + (m - MP)) * DPLE + c;
            const f32x4 a = *(const f32x4*)src, b = *(const f32x4*)(src + 4); *(u32x4*)(PB + e) = (u32x4){pk2(a[0], a[1]), pk2(a[2], a[3]), pk2(b[0], b[1]), pk2(b[2], b[3])}; }
        for (size_t e = (size_t)gtid * 8; e < (size_t)NBS * PAST * D; e += (size_t)GT * 8) { const size_t r = e / D; const int c = (int)(e % D); const size_t b = r / PAST, pos = r % PAST; const size_t d = (b * LKS + pos) * D + c;
            { const f32x4 a = *(const f32x4*)(cache_k + e), bb = *(const f32x4*)(cache_k + e + 4); *(u32x4*)(KS + d) = (u32x4){pk2(a[0], a[1]), pk2(a[2], a[3]), pk2(bb[0], bb[1]), pk2(bb[2], bb[3])}; }
            { const f32x4 a = *(const f32x4*)(cache_v + e), bb = *(const f32x4*)(cache_v + e + 4); *(u32x4*)(VS + d) = (u32x4){pk2(a[0], a[1]), pk2(a[2], a[3]), pk2(bb[0], bb[1]), pk2(bb[2], bb[3])}; } }
        for (int c = gtid; c < D; c += GT) { lbv[c] = 0.f; lbv[D + c] = 1.0f / (1.0f + expf(lb_logits[c] - lb_logits[D + c])); }
        SEAM(0);
    }

#pragma unroll 1
    for (int L = 0; L < 4; ++L) {
        const int pb = 1 + 6 * L; const bool isA = L < 2; const int j = L - 2;
        if (IN(pb)) { SITE_FRAME();
            if (SITE(0) && isA) { pg8::Gemm g{XB, W_AIN + (size_t)L * 4 * D * D, M, 4 * D, D}; pg8::StaticOrder S; S.init(M, 4 * D, G, bx);
                pg8::EpiAin E{ss + (size_t)(2 * L) * M, lbv + L * D, ZQ, ZG, ZV, ZGATE};
                pg8::gemm_phase<pg8::EpiAin, pg8::StaticOrder, true, true>(lds, g, S, E);
            } else if (SITE(1) && !isA) { const int N = (j == 0) ? NKVQ : 2 * D; pg8::Gemm g{XB, j == 0 ? W_KVQ : W_BIN1, M, N, D}; pg8::StaticOrder S; S.init(M, N, G, bx);
                pg8::EpiBin E{ss + (size_t)(2 * L) * M, j == 0 ? 0 : 2, KP, VP, KS, VS, ZQ, ZGATE, out, LF, b_f};
                pg8::gemm_phase<pg8::EpiBin, pg8::StaticOrder, true, true>(lds, g, S, E); }
            if (SITE(2)) { int kple = DPLE; asm volatile("" : "+s"(kple));
              pg8::Gemm g{PB + (size_t)L * M * DPLE, W_PIN + (size_t)L * D * DPLE, M, D, kple}; pg8::StaticOrder S; S.init(M, D, G, bx);
              pg8::EpiBf16 E{EB, D};
              pg8::gemm_phase<pg8::EpiBf16, pg8::StaticOrder, true, true>(lds, g, S, E); }
            SEAM(pb);
        }
        if (IN(pb + 1) && phase_nonempty(pb + 1)) { SITE_FRAME();
            if (SITE(3) && isA) {
                for (int u = vcu; u < 32 * (NSEG - 1); u += G) { const int stream = u / (NSEG - 1), seg = u % (NSEG - 1), b = stream >> 4, h = stream & 15;
                    hgrn_unit<false>(lds, tid, nullptr, ZG, ZV, nullptr, nullptr, nullptr, b * TP + seg * (SEGC * CH), SEGC, h, nullptr, LSEG + ((size_t)(stream * NSEG + seg) << 14), gseg + (size_t)(stream * NSEG + seg) * HD); }
            } else if (SITE(4) && !isA) {
                for (int u = vcu; u < 32 + 256; u += G) {
                    if (u < 32) { const int b = u >> 4, h = u & 15; cumsum_unit<32>(lds, tid, LF + (size_t)b * TP * H + h, TP, H, nullptr, 0, TP, Dp + (size_t)u * TP); }
                    else { const int v = u - 32, b = v >> 4, h = v & 15; cumsum_unit<3>(lds, tid, cache_logf + (size_t)b * PAST * H + h, PAST, H, LF + (size_t)(MP + b * TS) * H + h, H, LKS, Ds + (size_t)v * LKS); } }
            }
            SEAM(pb + 1);
        }
        if (SITE(5) && IN(pb + 2) && phase_nonempty(pb + 2)) { SITE_FRAME(); hgrn_scan(gtid, GT, LSEG, gseg, SSTART); SEAM(pb + 2); }
        if (IN(pb + 3)) { SITE_FRAME();
            if (SITE(6) && isA) {
                for (int u = vcu; u < 32 * NSEG + NBS * H; u += G) {
                    if (u < 32 * NSEG) { const int stream = u / NSEG, seg = u % NSEG, b = stream >> 4, h = stream & 15;
                        hgrn_unit<true>(lds, tid, ZQ, ZG, ZV, ZGATE, g_out_a + L * D, OB, b * TP + seg * (SEGC * CH), SEGC, h, seg ? SSTART + ((size_t)(stream * NSEG + seg) << 14) : nullptr,
                                        seg == NSEG - 1 ? out + O_STP + ((size_t)(L * NBP * H + stream) << 14) : nullptr, nullptr); }
                    else { const int v = u - 32 * NSEG, b = v >> 4, h = v & 15;
                        hgrn_unit<true>(lds, tid, ZQ, ZG, ZV, ZGATE, g_out_a + L * D, OB, MP + b * TS, 1, h, state_hgrn + ((size_t)(L * NBS * H + v) << 14), out + O_STS + ((size_t)(L * NBS * H + v) << 14), nullptr); } }
            } else if (SITE(7) && !isA) {
                for (int u = vcu; u < 1024 + 256; u += G) {
                    if (u < 1024) { const int bh = u >> 5, x = u & 31, b = bh >> 4, h = bh & 15; const size_t co = (size_t)h * HD;
#pragma unroll 1
                        for (int t = 0; t < 2; ++t) { const int qb = t ? 63 - x : x; const size_t r0 = (size_t)b * TP + 256 * qb;
                            attn_block(lds, tid, ZQ + r0 * D + co, ZGATE + r0 * D + co, OB + r0 * D + co, KP + (size_t)b * TP * D + co, VP + (size_t)b * TP * D + co, Dp + (size_t)bh * TP, 256 * qb, 256); } }
                    else { const int v = u - 1024, b = v >> 4, h = v & 15; const size_t co = (size_t)h * HD, r0 = (size_t)MP + b * TS;
                        attn_block(lds, tid, ZQ + r0 * D + co, ZGATE + r0 * D + co, OB + r0 * D + co, KS + (size_t)b * LKS * D + co, VS + (size_t)b * LKS * D + co, Ds + (size_t)v * LKS, PAST, TS); } }
            }
            SEAM(pb + 3);
        }
        if (SITE(8) && IN(pb + 4)) { SITE_FRAME(); pg8::Gemm g{OB, (isA ? W_AOUT + (size_t)L * D * D : W_BOUT + (size_t)j * D * D), M, D, D}; pg8::StaticOrder S; S.init(M, D, G, bx);
            pg8::EpiRes<false> E{L == 0 ? x_prompt : X, L == 0 ? x_sample : X + (size_t)MP * D, X, X + (size_t)MP * D, XB2, ss + (size_t)(2 * L + 1) * M, nullptr, nullptr};
            pg8::gemm_phase<pg8::EpiRes<false>, pg8::StaticOrder, true, true>(lds, g, S, E);
            SEAM(pb + 4); }
        if (SITE(9) && IN(pb + 5)) { SITE_FRAME(); pg8::Gemm g{XB2, W_PG + (size_t)L * D * D, M, D, D}; pg8::StaticOrder S; S.init(M, D, G, bx);
            pg8::EpiRes<true> E{X, X + (size_t)MP * D, L == 3 ? out + O_YP : X, L == 3 ? out + O_YS : X + (size_t)MP * D, XB, ss + (size_t)(2 * L + 2) * M, ss + (size_t)(2 * L + 1) * M, EB};
            pg8::gemm_phase<pg8::EpiRes<true>, pg8::StaticOrder, true, true>(lds, g, S, E);
            SEAM(pb + 5); }
    }
    if (SITE(11) && IN(25)) { SITE_FRAME();
        const float* s8 = ss + (size_t)8 * M;
        for (int m = gw; m < M; m += NGW) { float* yr = out + O_YP + (size_t)m * D; const float rstd = frsq(s8[m] * (1.0f / D) + EPS);
#pragma unroll
            for (int jj = 0; jj < 8; ++jj) { const int c = 256 * jj + 4 * lane; const f32x4 v = *(const f32x4*)(yr + c), gv = *(const f32x4*)(g_final + c); *(f32x4*)(yr + c) = v * rstd * gv; } }
    }
#undef IN
#undef SEAM
}
#undef x_prompt
#undef x_sample
#undef state_hgrn
#undef cache_k
#undef cache_v
#undef cache_logf
#undef p_prompt
#undef p_sample
#undef g_norm_a
#undef w_in_a
#undef lb_logits
#undef g_out_a
#undef w_out_a
#undef g_kv
#undef w_kv
#undef b_f
#undef g_norm_b
#undef w_in_b
#undef w_out_b
#undef w_ple_in
#undef g_ple
#undef w_ple_gate
#undef g_final
#undef ss
#undef lbv
#undef gseg
#undef Dp
#undef Ds
#undef LF
#undef W_AIN
#undef W_AOUT
#undef W_KVQ
#undef W_BIN1
#undef W_BOUT
#undef W_PIN
#undef W_PG
#undef X
#undef XB
#undef XB2
#undef ZQ
#undef ZG
#undef ZV
#undef ZGATE
#undef OB
#undef EB
#undef PB
#undef KS
#undef VS
#undef KP
#undef VP
#undef LSEG
#undef SSTART
#undef out

extern "C" void kernel_launch(void* const* d_in, const int* in_sizes, int n_in, void* d_out, int out_size, void* d_ws, size_t ws_size, hipStream_t stream) {
    static int grid = 0;
    if (grid == 0) {
        if (n_in != 23 || (size_t)out_size != O_END || ws_size < WS_END) { fprintf(stderr, "kernel_launch: unexpected shapes (n_in %d, out %d, ws %zu); nothing launched\n", n_in, out_size, ws_size); grid = -1; return; }
        int dev = 0, cus = 0, per_cu = 0;
        if (hipGetDevice(&dev) != hipSuccess || hipDeviceGetAttribute(&cus, hipDeviceAttributeMultiprocessorCount, dev) != hipSuccess) { grid = -1; return; }
        if (hipFuncSetAttribute((const void*)fwd, hipFuncAttributeMaxDynamicSharedMemorySize, LDS_BYTES) != hipSuccess) { fprintf(stderr, "kernel_launch: hipFuncSetAttribute failed\n"); grid = -1; return; }
        if (hipOccupancyMaxActiveBlocksPerMultiprocessor(&per_cu, (const void*)fwd, NWAVES * 64, LDS_BYTES) != hipSuccess || per_cu < 1) { fprintf(stderr, "kernel_launch: occupancy query says %d\n", per_cu); }
        (void)hipGetLastError();
        grid = cus;
    }
    if (grid < 0) return;
    (void)hipMemsetAsync((char*)d_ws + WS_CTL, 0, CTL_ZERO_BYTES, stream);
    Args a{};
    for (int i = 0; i < 23; ++i) a.in[i] = (const float*)d_in[i];
    a.out = (float*)d_out; a.ws = (unsigned char*)d_ws;
#ifndef MK_PER_PHASE
    a.ph_lo = 0; a.ph_hi = N_PHASES;
    hipLaunchKernelGGL(fwd, dim3(grid), dim3(NWAVES * 64), LDS_BYTES, stream, a);
#else
    for (int p = 0; p < N_PHASES; ++p) { if (!phase_nonempty(p)) continue; a.ph_lo = p; a.ph_hi = p + 1; hipLaunchKernelGGL(fwd, dim3(grid), dim3(NWAVES * 64), LDS_BYTES, stream, a); }
#endif
}
#endif
```

```cpp
#ifndef EMU_HOST
#include <hip/hip_runtime.h>
#endif
#include <cstdio>
#include <cstdint>

constexpr int D = 2048, H = 16, HD = 128, DPLE = 256;
constexpr int NBP = 2, TP = 16384, MP = NBP * TP;
constexpr int NBS = 16, TS = 64, MS = NBS * TS;
constexpr int M = MP + MS;
constexpr int PAST = 1024, LKS = PAST + TS;
constexpr int NSEG = 16, SEGC = 16, CH = 64;
constexpr int NKVQ = 8448;
constexpr float EPS = 1e-6f;
constexpr float LOG2E = 1.4426950408889634f;

constexpr size_t O_YP = 0, O_YS = O_YP + (size_t)MP * D, O_STP = O_YS + (size_t)MS * D, O_STS = O_STP + (size_t)2 * NBP * H * HD * HD,
                 O_KP = O_STS + (size_t)2 * NBS * H * HD * HD, O_VP = O_KP + (size_t)MP * D, O_LFP = O_VP + (size_t)MP * D, O_KS = O_LFP + (size_t)MP * H,
                 O_VS = O_KS + (size_t)MS * D, O_LFS = O_VS + (size_t)MS * D, O_END = O_LFS + (size_t)MS * H;
static_assert(O_END == 217595904ull, "output size");

constexpr size_t MiB = 1u << 20;
constexpr size_t WS_CTL = 0, CTL_ZERO_BYTES = 3 * MiB;
constexpr size_t WS_SS = 1 * MiB;
constexpr size_t WS_LBV = 3 * MiB;
constexpr size_t WS_GSEG = 3 * MiB + 64 * 1024;
constexpr size_t WS_DP = 4 * MiB, WS_DS = 6 * MiB, WS_LF = 8 * MiB;
constexpr size_t WS_WAIN = 12 * MiB, WS_WAOUT = 76 * MiB, WS_WKVQ = 92 * MiB, WS_WBIN1 = 125 * MiB, WS_WBOUT = 141 * MiB, WS_WPIN = 157 * MiB, WS_WPG = 161 * MiB;
constexpr size_t WS_X = 193 * MiB, WS_XB = 457 * MiB, WS_ZQ = 589 * MiB, WS_ZG = 721 * MiB, WS_ZV = 853 * MiB, WS_ZGATE = 985 * MiB, WS_OB = 1117 * MiB, WS_EB = 1249 * MiB;
constexpr size_t WS_PB = 1381 * MiB, WS_KS = 1447 * MiB, WS_VS = 1515 * MiB, WS_LSEG = 1583 * MiB, WS_SSTART = 1615 * MiB, WS_XB2 = 1647 * MiB, WS_END = 1779 * MiB;
constexpr size_t WS_KP = WS_ZG, WS_VP = WS_ZV;
static_assert(WS_SS + 9ull * M * 4 <= CTL_ZERO_BYTES && (size_t)M * D * 2 == 132 * MiB && (size_t)NKVQ * D * 2 <= 33 * MiB && (size_t)NBS * LKS * D * 2 <= 68 * MiB, "ws map");
constexpr int CW_TMO = 0, CW_BAR = 4096, CW_KMAX = 8192;

constexpr int RING_BYTES = 131072, LDSCTL_OFF = RING_BYTES, MISC_OFF = LDSCTL_OFF + 320, LDS_BYTES = 147456, NWAVES = 8;

typedef unsigned short bf16_t;
typedef short bf16x8 __attribute__((ext_vector_type(8)));
typedef float f32x4 __attribute__((ext_vector_type(4)));
typedef float f32x2 __attribute__((ext_vector_type(2)));
typedef unsigned u32x4 __attribute__((ext_vector_type(4)));
typedef unsigned u32x2 __attribute__((ext_vector_type(2)));
typedef _Float16 h16x2 __attribute__((ext_vector_type(2)));

#ifndef EMU_HOST
#define DEV __device__ __forceinline__
#define GAS __attribute__((address_space(1)))
#define LAS __attribute__((address_space(3)))
#define BLOCK_SYNC() __syncthreads()
#define SHFL_XOR(v, m) __shfl_xor((v), (m))
#define MFMA16(a, b, c) __builtin_amdgcn_mfma_f32_16x16x32_bf16((a), (b), (c), 0, 0, 0)
#define ATOMIC_ADD_F32(p, v) ((void)__hip_atomic_fetch_add((p), (v), __ATOMIC_RELAXED, __HIP_MEMORY_SCOPE_AGENT))
#define ATOMIC_MAX_U32(p, v) ((void)__hip_atomic_fetch_max((p), (v), __ATOMIC_RELAXED, __HIP_MEMORY_SCOPE_AGENT))
DEV float fexp(float x) { return __expf(x); }
DEV float fexp2(float x) { return __builtin_amdgcn_exp2f(x); }
DEV float flog(float x) { return __logf(x); }
DEV float frcp(float x) { return __builtin_amdgcn_rcpf(x); }
DEV float frsq(float x) { return __builtin_amdgcn_rsqf(x); }
DEV unsigned pk2(float lo, float hi) { unsigned r; asm volatile("v_cvt_pk_bf16_f32 %0, %1, %2" : "=v"(r) : "v"(lo), "v"(hi)); return r; }
#endif
DEV float bf_lo(unsigned w) { return __builtin_bit_cast(float, w << 16); }
DEV float bf_hi(unsigned w) { return __builtin_bit_cast(float, w & 0xffff0000u); }
DEV float bf2f(bf16_t b) { return __builtin_bit_cast(float, (unsigned)b << 16); }
DEV unsigned pkh2(float lo, float hi) { h16x2 t = {(_Float16)lo, (_Float16)hi}; return __builtin_bit_cast(unsigned, t); }
DEV float h_lo(unsigned w) { h16x2 t = __builtin_bit_cast(h16x2, w); return (float)t.x; }
DEV float h_hi(unsigned w) { h16x2 t = __builtin_bit_cast(h16x2, w); return (float)t.y; }
DEV float sigmoidf_(float z) { return frcp(1.0f + fexp(-z)); }
DEV float siluf_(float z) { return z * frcp(1.0f + fexp(-z)); }

#ifndef EMU_HOST
namespace pg8 {
#define PG8_LAS __attribute__((address_space(3)))
typedef unsigned short bf16_t;
typedef short bf16x8 __attribute__((ext_vector_type(8)));
typedef float f32x4 __attribute__((ext_vector_type(4)));
typedef unsigned u32x4 __attribute__((ext_vector_type(4)));
constexpr int BM = 256, BK = 64, HALF = 128, HTB = HALF * BK * 2  , STAGE_BYTES = 8 * HTB, NXCD = 8, WGM = 8;

__host__ __device__ __forceinline__ int lds_byte(int r, int c) { const int st = (r >> 4) * 2 + (c >> 5), rr = r & 15, cc = c & 31, ob = rr * 64 + cc * 2; return st * 1024 + (ob ^ (((ob >> 9) & 1) << 5)); }
__host__ __device__ __forceinline__ void stage_rc(int b, int& R, int& C) { const int st = b / 1024, sb = b % 1024, swz = sb ^ (((sb >> 9) & 1) << 5); R = (st >> 1) * 16 + swz / 64; C = (st & 1) * 32 + (swz % 64) / 2; }
__host__ __device__ __forceinline__ int perm32(int rho) { const int n = rho >> 4, i = rho & 15; return 8 * (i >> 2) + 4 * n + (i & 3); }

struct Unit { int pm, pn; };
struct Gemm { const bf16_t* A; const bf16_t* Bt; int M, N, K; };

struct StaticOrder {
    int nM, nN, nwg, G, c;
    __host__ __device__ void init(int M, int N, int G_, int c_) { nM = M / BM; nN = N / BM; nwg = nM * nN; G = G_; c = c_; }
    __host__ __device__ bool next(int i, Unit& u) const {
        const long L = (long)i * G + c; if (L >= nwg) return false;
        int wgid = (int)L; { const int q = nwg / NXCD, r = nwg % NXCD, xcd = wgid % NXCD, off = wgid / NXCD; wgid = (xcd < r ? xcd * (q + 1) : r * (q + 1) + (xcd - r) * q) + off; }
        const int nig = WGM * nN, gid = wgid / nig, fm = gid * WGM, gsz = (nM - fm) < WGM ? (nM - fm) : WGM;
        u.pm = fm + ((wgid % nig) % gsz); u.pn = (wgid % nig) / gsz; return true;
    }
    __device__ __forceinline__ void a_ready(const Unit&) const {}
    __device__ __forceinline__ void done(const Unit&) const {}
};

__device__ __forceinline__ unsigned cvt_pk_bf16(float lo, float hi) { unsigned r; asm volatile("v_cvt_pk_bf16_f32 %0, %1, %2" : "=v"(r) : "v"(lo), "v"(hi)); return r; }
typedef float f32x2 __attribute__((ext_vector_type(2)));

struct EpiBf16 {
    static constexpr bool PERM = true, AFTER_DRAIN = false;
    bf16_t* O; int ldc;
    __device__ __forceinline__ void operator()(const f32x4 (&acc)[2][2][4][2], const Unit& u, int wr, int wc, int fr, int fq) const {
        const int row0 = u.pm * BM + wr * 64 + fr, col0 = u.pn * BM + wc * 32 + 8 * fq;
#pragma unroll
        for (int ai = 0; ai < 2; ++ai)
#pragma unroll
            for (int m = 0; m < 4; ++m) { bf16_t* rowp = O + (size_t)(row0 + ai * HALF + m * 16) * ldc + col0;
#pragma unroll
                for (int bj = 0; bj < 2; ++bj) { const f32x4 v0 = acc[ai][bj][m][0], v1 = acc[ai][bj][m][1];
                    u32x4 w; w.x = cvt_pk_bf16(v0[0], v0[1]); w.y = cvt_pk_bf16(v0[2], v0[3]); w.z = cvt_pk_bf16(v1[0], v1[1]); w.w = cvt_pk_bf16(v1[2], v1[3]);
                    *(u32x4*)(rowp + bj * HALF) = w; } }
    }
};

struct EpiAin {
    static constexpr bool PERM = true, AFTER_DRAIN = false;
    const float* ss; const float* lb; bf16_t* zq; bf16_t* zg; bf16_t* zv; bf16_t* zgate;
    template <int TYPE> __device__ __forceinline__ void run(const f32x4 (&acc)[2][2][4][2], const Unit& u, int wr, int wc, int fr, int fq, bf16_t* base) const {
        const int ct = (u.pn & 7) * BM + wc * 32 + 8 * fq, row0 = u.pm * BM + wr * 64 + fr;
#pragma unroll
        for (int ai = 0; ai < 2; ++ai)
#pragma unroll
            for (int m = 0; m < 4; ++m) { const int row = row0 + ai * HALF + m * 16; const float rstd = frsq(ss[row] * (1.0f / D) + EPS);
                bf16_t* rowp = base + (size_t)row * D + ct;
#pragma unroll
                for (int bj = 0; bj < 2; ++bj) { f32x4 v0 = acc[ai][bj][m][0] * rstd, v1 = acc[ai][bj][m][1] * rstd; u32x4 w;
                    if (TYPE == 1) {
                        const f32x4 l0 = *(const f32x4*)(lb + ct + bj * HALF), l1 = *(const f32x4*)(lb + ct + bj * HALF + 4);
#pragma unroll
                        for (int j = 0; j < 4; ++j) { v0[j] = fmaxf(flog(l0[j] + (1.0f - l0[j]) * sigmoidf_(v0[j])), -80.0f); v1[j] = fmaxf(flog(l1[j] + (1.0f - l1[j]) * sigmoidf_(v1[j])), -80.0f); }
                        w.x = pkh2(v0[0], v0[1]); w.y = pkh2(v0[2], v0[3]); w.z = pkh2(v1[0], v1[1]); w.w = pkh2(v1[2], v1[3]);
                    } else {
                        if (TYPE == 0) {
#pragma unroll
                            for (int j = 0; j < 4; ++j) { v0[j] = siluf_(v0[j]); v1[j] = siluf_(v1[j]); } }
                        w.x = cvt_pk_bf16(v0[0], v0[1]); w.y = cvt_pk_bf16(v0[2], v0[3]); w.z = cvt_pk_bf16(v1[0], v1[1]); w.w = cvt_pk_bf16(v1[2], v1[3]);
                    }
                    *(u32x4*)(rowp + bj * HALF) = w; } }
    }
    __device__ __forceinline__ void operator()(const f32x4 (&acc)[2][2][4][2], const Unit& u, int wr, int wc, int fr, int fq) const {
        const int type = u.pn >> 3;
        if (type == 0) run<0>(acc, u, wr, wc, fr, fq, zq); else if (type == 1) run<1>(acc, u, wr, wc, fr, fq, zg); else if (type == 2) run<2>(acc, u, wr, wc, fr, fq, zv); else run<0>(acc, u, wr, wc, fr, fq, zgate);
    }
};

struct EpiBin {
    static constexpr bool PERM = true, AFTER_DRAIN = false;
    const float* ss; int tbase; bf16_t* kp; bf16_t* vp; bf16_t* ks; bf16_t* vs; bf16_t* zq; bf16_t* zgate; float* out; float* lf; const float* bf;
    template <int TYPE> __device__ __forceinline__ void run(const f32x4 (&acc)[2][2][4][2], const Unit& u, int wr, int wc, int fr, int fq) const {
        const int ct = (u.pn & 7) * BM + wc * 32 + 8 * fq, row0 = u.pm * BM + wr * 64 + fr; const bool smp = u.pm >= MP / BM;
#pragma unroll
        for (int ai = 0; ai < 2; ++ai)
#pragma unroll
            for (int m = 0; m < 4; ++m) { const int row = row0 + ai * HALF + m * 16; const float rstd = frsq(ss[row] * (1.0f / D) + EPS);
                const int ms = row - MP;
                if (TYPE == 4) {
                    if (wc == 0 && fq < 2) { const f32x4 v0 = acc[ai][0][m][0] * rstd + *(const f32x4*)(bf + 8 * fq), v1 = acc[ai][0][m][1] * rstd + *(const f32x4*)(bf + 8 * fq + 4); f32x4 r0, r1;
#pragma unroll
                        for (int j = 0; j < 4; ++j) { r0[j] = fminf(v0[j], 0.f) - log1pf(expf(-fabsf(v0[j]))); r1[j] = fminf(v1[j], 0.f) - log1pf(expf(-fabsf(v1[j]))); }
                        float* o = smp ? out + O_LFS + (size_t)ms * H + 8 * fq : out + O_LFP + (size_t)row * H + 8 * fq; float* l = lf + (size_t)row * H + 8 * fq;
                        *(f32x4*)o = r0; *(f32x4*)(o + 4) = r1; *(f32x4*)l = r0; *(f32x4*)(l + 4) = r1; }
                } else {
                    bf16_t* rowp; float* orow = nullptr;
                    if (TYPE == 0 || TYPE == 1) {
                        if (smp) { const size_t kr = (size_t)(ms / TS) * LKS + PAST + (ms % TS); rowp = (TYPE == 0 ? ks : vs) + kr * D + ct; orow = out + (TYPE == 0 ? O_KS : O_VS) + (size_t)ms * D + ct; }
                        else { rowp = (TYPE == 0 ? kp : vp) + (size_t)row * D + ct; orow = out + (TYPE == 0 ? O_KP : O_VP) + (size_t)row * D + ct; }
                    } else rowp = (TYPE == 2 ? zq : zgate) + (size_t)row * D + ct;
#pragma unroll
                    for (int bj = 0; bj < 2; ++bj) { f32x4 v0 = acc[ai][bj][m][0] * rstd, v1 = acc[ai][bj][m][1] * rstd;
                        if (TYPE == 0 || TYPE == 1) { *(f32x4*)(orow + bj * HALF) = v0; *(f32x4*)(orow + bj * HALF + 4) = v1; }
                        if (TYPE == 3) {
#pragma unroll
                            for (int j = 0; j < 4; ++j) { v0[j] = siluf_(v0[j]); v1[j] = siluf_(v1[j]); } }
                        u32x4 w; w.x = cvt_pk_bf16(v0[0], v0[1]); w.y = cvt_pk_bf16(v0[2], v0[3]); w.z = cvt_pk_bf16(v1[0], v1[1]); w.w = cvt_pk_bf16(v1[2], v1[3]);
                        *(u32x4*)(rowp + bj * HALF) = w; }
                } }
    }
    __device__ __forceinline__ void operator()(const f32x4 (&acc)[2][2][4][2], const Unit& u, int wr, int wc, int fr, int fq) const {
        const int type = (u.pn >> 3) + tbase;
        if (type == 0) run<0>(acc, u, wr, wc, fr, fq); else if (type == 1) run<1>(acc, u, wr, wc, fr, fq); else if (type == 2) run<2>(acc, u, wr, wc, fr, fq); else if (type == 3) run<3>(acc, u, wr, wc, fr, fq); else run<4>(acc, u, wr, wc, fr, fq);
    }
};

template <bool PLE> struct EpiRes {
    static constexpr bool PERM = false, AFTER_DRAIN = false;
    const float* xin_p; const float* xin_s; float* xout_p; float* xout_s; bf16_t* xb; float* ss_out; const float* ss_in; const bf16_t* e;
    __device__ __forceinline__ void operator()(const f32x4 (&acc)[2][2][4][2], const Unit& u, int wr, int wc, int fr, int fq) const {
        const int row0 = u.pm * BM + wr * 64 + fr, col0 = u.pn * BM + wc * 32 + 4 * fq; const bool smp = u.pm >= MP / BM;
        const float* xi = smp ? xin_s : xin_p; float* xo = smp ? xout_s : xout_p; const int rsub = smp ? MP : 0;
        float sacc[8];
#pragma unroll
        for (int ai = 0; ai < 2; ++ai)
#pragma unroll
            for (int m = 0; m < 4; ++m) { const int row = row0 + ai * HALF + m * 16; const size_t off = (size_t)row * D + col0, offx = (size_t)(row - rsub) * D + col0;
                float rstd = 1.f; if (PLE) rstd = frsq(ss_in[row] * (1.0f / D) + EPS);
                float s = 0.f;
#pragma unroll
                for (int bj = 0; bj < 2; ++bj)
#pragma unroll
                    for (int n = 0; n < 2; ++n) { const int o = bj * HALF + n * 16; const f32x4 xv = *(const f32x4*)(xi + offx + o); f32x4 a = acc[ai][bj][m][n];
                        if (PLE) { const u32x2 ev = *(const u32x2*)(e + off + o); a = a * rstd;
                            a[0] = sigmoidf_(a[0]) * bf_lo(ev.x); a[1] = sigmoidf_(a[1]) * bf_hi(ev.x); a[2] = sigmoidf_(a[2]) * bf_lo(ev.y); a[3] = sigmoidf_(a[3]) * bf_hi(ev.y); }
                        const f32x4 xn = xv + a; *(f32x4*)(xo + offx + o) = xn;
                        u32x2 w; w.x = cvt_pk_bf16(xn[0], xn[1]); w.y = cvt_pk_bf16(xn[2], xn[3]); *(u32x2*)(xb + off + o) = w;
                        s += (xn[0] * xn[0] + xn[1] * xn[1]) + (xn[2] * xn[2] + xn[3] * xn[3]); }
                s += __shfl_xor(s, 16); s += __shfl_xor(s, 32); sacc[ai * 4 + m] = s; }
#pragma unroll
        for (int j = 0; j < 2; ++j) { const float v = fq == 0 ? sacc[4 * j] : fq == 1 ? sacc[4 * j + 1] : fq == 2 ? sacc[4 * j + 2] : sacc[4 * j + 3];
            __hip_atomic_fetch_add(ss_out + row0 + j * HALF + fq * 16, v, __ATOMIC_RELAXED, __HIP_MEMORY_SCOPE_AGENT); }
    }
};

template <class Epi, class Sched, bool ALIGN_EPI = false, bool SP2 = false>
__device__ __forceinline__ void gemm_phase(PG8_LAS unsigned char* lds, const Gemm g, const Sched& S, const Epi& E, const int wave_in) {
    int tid_; asm volatile("v_mbcnt_lo_u32_b32 %0, -1, 0\n\tv_mbcnt_hi_u32_b32 %0, -1, %0" : "=v"(tid_)); tid_ += wave_in * 64;
    const int tid = tid_, wid = __builtin_amdgcn_readfirstlane(tid >> 6), lane = tid & 63, wr = wid >> 2, wc = wid & 3, fr = lane & 15, fq = lane >> 4;
    const int K = g.K, nt = K / BK;
    unsigned voffA[2], voffB[2];
#pragma unroll
    for (int i = 0; i < 2; ++i) { int R, C; stage_rc(tid * 16 + i * 8192, R, C); const int Rb = Epi::PERM ? ((R & ~31) + perm32(R & 31)) : R;
        voffA[i] = (unsigned)(R * K + C) * 2u; voffB[i] = (unsigned)(Rb * K + C) * 2u; }
    const size_t kstep = (size_t)(BK * 2);
    const size_t hstep = (size_t)HALF * K * 2;
    const size_t tstep = 2 * hstep;
    const unsigned ldsw = (unsigned)wid * 1024u;
    const int aoff = lds_byte(wr * 64 + fr, fq * 8), boff = lds_byte(wc * 32 + fr, fq * 8);
#define PG8_SA(b, h) (((b) * 2 + (h)) * HTB)
#define PG8_SB(b, h) ((4 + (b) * 2 + (h)) * HTB)
#define PG8_STAGE(bufoff, gbase, voff) do { _Pragma("unroll") for (int _i = 0; _i < 2; ++_i) \
        __builtin_amdgcn_global_load_lds((const unsigned*)((const char*)(gbase) + (voff)[_i]), (PG8_LAS unsigned*)(lds + (bufoff) + ldsw + _i * 8192), 16, 0, 0); } while (0)
#define PG8_LDA(dst, b, h) do { _Pragma("unroll") for (int m = 0; m < 4; ++m) _Pragma("unroll") for (int k = 0; k < 2; ++k) dst[m][k] = *(const PG8_LAS bf16x8*)(lds + PG8_SA(b, h) + aoff + m * 2048 + k * 1024); } while (0)
#define PG8_LDB(dst, b, h) do { _Pragma("unroll") for (int n = 0; n < 2; ++n) _Pragma("unroll") for (int k = 0; k < 2; ++k) dst[n][k] = *(const PG8_LAS bf16x8*)(lds + PG8_SB(b, h) + boff + n * 2048 + k * 1024); } while (0)
#define PG8_MMA(ai, bj, At, Bt) do { __builtin_amdgcn_s_setprio(1); _Pragma("unroll") for (int m = 0; m < 4; ++m) _Pragma("unroll") for (int n = 0; n < 2; ++n) _Pragma("unroll") for (int k = 0; k < 2; ++k) \
        acc[ai][bj][m][n] = __builtin_amdgcn_mfma_f32_16x16x32_bf16(Bt[n][k], At[m][k], acc[ai][bj][m][n], 0, 0, 0); __builtin_amdgcn_s_setprio(0); } while (0)
#define PG8_WAIT_V(n) asm volatile("s_waitcnt vmcnt(" #n ")" ::: "memory")
#define PG8_WAIT_L(n) asm volatile("s_waitcnt lgkmcnt(" #n ")" ::: "memory")
#define PG8_BAR __builtin_amdgcn_s_barrier()
#define PG8_SCHED __builtin_amdgcn_sched_barrier(0)
    Unit cur, nxt; int ui = 0;
    if (!S.next(0, cur)) return;
    f32x4 acc[2][2][4][2];
#pragma unroll
    for (int a = 0; a < 2; ++a)
#pragma unroll
        for (int b = 0; b < 2; ++b)
#pragma unroll
            for (int m = 0; m < 4; ++m)
#pragma unroll
                for (int n = 0; n < 2; ++n) acc[a][b][m][n] = (f32x4){0.f, 0.f, 0.f, 0.f};
    bf16x8 At[4][2], B0[2][2], B1[2][2];
    const char* cA = (const char*)g.A + (size_t)cur.pm * tstep; const char* cB = (const char*)g.Bt + (size_t)cur.pn * tstep;
    S.a_ready(cur);
    if constexpr (SP2) {
        PG8_STAGE(PG8_SB(0, 0), cB, voffB); PG8_STAGE(PG8_SB(0, 1), cB + hstep, voffB); PG8_STAGE(PG8_SA(0, 0), cA, voffA); PG8_STAGE(PG8_SA(0, 1), cA + hstep, voffA);
        if (wr == 1) PG8_BAR;
        PG8_WAIT_V(2); PG8_BAR;
        PG8_STAGE(PG8_SB(1, 0), cB + kstep, voffB); PG8_STAGE(PG8_SA(1, 0), cA + kstep, voffA); PG8_STAGE(PG8_SB(1, 1), cB + hstep + kstep, voffB);
        PG8_WAIT_V(6); PG8_BAR;
    } else {
        PG8_STAGE(PG8_SB(0, 0), cB, voffB); PG8_STAGE(PG8_SA(0, 0), cA, voffA); PG8_STAGE(PG8_SB(0, 1), cB + hstep, voffB); PG8_STAGE(PG8_SA(0, 1), cA + hstep, voffA);
        if (wr == 1) PG8_BAR;
        PG8_WAIT_V(4); PG8_BAR;
        PG8_STAGE(PG8_SB(1, 0), cB + kstep, voffB); PG8_STAGE(PG8_SA(1, 0), cA + kstep, voffA); PG8_STAGE(PG8_SB(1, 1), cB + hstep + kstep, voffB);
        PG8_WAIT_V(6); PG8_BAR;
    }
    for (;;) {
        const bool has_next = S.next(ui + 1, nxt);
        const char* nA = has_next ? (const char*)g.A + (size_t)nxt.pm * tstep : cA; const char* nB = has_next ? (const char*)g.Bt + (size_t)nxt.pn * tstep : cB;
        for (int t = 0; t < nt; t += 2) {
            const bool last = (t == nt - 2);
            const char* a1 = cA + (size_t)(t + 1) * kstep;
            const char* a2 = last ? nA : cA + (size_t)(t + 2) * kstep; const char* b2 = last ? nB : cB + (size_t)(t + 2) * kstep;
            const char* a3 = a2 + kstep; const char* b3 = b2 + kstep;
            if (last && has_next) S.a_ready(nxt);
            if constexpr (SP2) {
            PG8_LDB(B0, 0, 0); PG8_LDB(B1, 0, 1); PG8_SCHED; PG8_LDA(At, 0, 0); PG8_STAGE(PG8_SA(1, 1), a1 + hstep, voffA);
            PG8_WAIT_V(8); PG8_WAIT_L(0); PG8_BAR; PG8_MMA(0, 0, At, B0); PG8_MMA(0, 1, At, B1); PG8_BAR; PG8_SCHED;
            PG8_LDA(At, 0, 1); PG8_STAGE(PG8_SB(0, 0), b2, voffB); PG8_STAGE(PG8_SB(0, 1), b2 + hstep, voffB); PG8_STAGE(PG8_SA(0, 0), a2, voffA);
            PG8_WAIT_V(8); PG8_WAIT_L(0); PG8_BAR; PG8_MMA(1, 0, At, B0); PG8_MMA(1, 1, At, B1); PG8_BAR; PG8_SCHED;
            PG8_LDB(B0, 1, 0); PG8_LDB(B1, 1, 1); PG8_SCHED; PG8_LDA(At, 1, 0); PG8_STAGE(PG8_SA(0, 1), a2 + hstep, voffA);
            PG8_WAIT_V(8); PG8_WAIT_L(0); PG8_BAR; PG8_MMA(0, 0, At, B0); PG8_MMA(0, 1, At, B1); PG8_BAR; PG8_SCHED;
            PG8_LDA(At, 1, 1); PG8_STAGE(PG8_SB(1, 0), b3, voffB); PG8_STAGE(PG8_SB(1, 1), b3 + hstep, voffB); PG8_STAGE(PG8_SA(1, 0), a3, voffA);
            PG8_WAIT_V(8); PG8_WAIT_L(0); PG8_BAR; PG8_MMA(1, 0, At, B0); PG8_MMA(1, 1, At, B1); PG8_BAR; PG8_SCHED;
            } else {
            PG8_LDB(B0, 0, 0); PG8_SCHED; PG8_LDA(At, 0, 0); PG8_STAGE(PG8_SA(1, 1), a1 + hstep, voffA);
            PG8_WAIT_L(8); PG8_BAR; PG8_WAIT_L(0); PG8_MMA(0, 0, At, B0); PG8_BAR; PG8_SCHED;
            PG8_LDB(B1, 0, 1); PG8_STAGE(PG8_SB(0, 0), b2, voffB);
            PG8_BAR; PG8_WAIT_L(0); PG8_MMA(0, 1, At, B1); PG8_BAR;
            PG8_LDA(At, 0, 1); PG8_STAGE(PG8_SA(0, 0), a2, voffA);
            PG8_BAR; PG8_WAIT_L(0); PG8_MMA(1, 0, At, B0); PG8_BAR; PG8_SCHED;
            PG8_STAGE(PG8_SB(0, 1), b2 + hstep, voffB);
            PG8_WAIT_V(6); PG8_BAR; PG8_MMA(1, 1, At, B1); PG8_BAR;
            PG8_LDB(B0, 1, 0); PG8_SCHED; PG8_LDA(At, 1, 0); PG8_STAGE(PG8_SA(0, 1), a2 + hstep, voffA);
            PG8_WAIT_L(8); PG8_BAR; PG8_WAIT_L(0); PG8_MMA(0, 0, At, B0); PG8_BAR; PG8_SCHED;
            PG8_LDB(B1, 1, 1); PG8_STAGE(PG8_SB(1, 0), b3, voffB);
            PG8_BAR; PG8_WAIT_L(0); PG8_MMA(0, 1, At, B1); PG8_BAR;
            PG8_LDA(At, 1, 1); PG8_STAGE(PG8_SA(1, 0), a3, voffA);
            PG8_BAR; PG8_WAIT_L(0); PG8_MMA(1, 0, At, B0); PG8_BAR; PG8_SCHED;
            PG8_STAGE(PG8_SB(1, 1), b3 + hstep, voffB);
            PG8_WAIT_V(6); PG8_BAR; PG8_MMA(1, 1, At, B1); PG8_BAR;
            }
        }
        if constexpr (ALIGN_EPI) { if (wr == 0) PG8_BAR; }
        if constexpr (!Epi::AFTER_DRAIN) { E(acc, cur, wr, wc, fr, fq); S.done(cur); }
        if (!has_next) break;
#pragma unroll
        for (int a = 0; a < 2; ++a)
#pragma unroll
            for (int b = 0; b < 2; ++b)
#pragma unroll
                for (int m = 0; m < 4; ++m)
#pragma unroll
                    for (int n = 0; n < 2; ++n) acc[a][b][m][n] = (f32x4){0.f, 0.f, 0.f, 0.f};
        cur = nxt; cA = nA; cB = nB; ++ui;
        if constexpr (ALIGN_EPI) { if (wr == 1) PG8_BAR; }
    }
    PG8_WAIT_V(0);
    if constexpr (!ALIGN_EPI) { if (wr == 0) PG8_BAR; }
    PG8_BAR;
    if constexpr (Epi::AFTER_DRAIN) { E.fused(acc, cur, wr, wc, fr, fq, lds, wid, lane); S.done(cur); }
#undef PG8_SA
#undef PG8_SB
#undef PG8_STAGE
#undef PG8_LDA
#undef PG8_LDB
#undef PG8_MMA
#undef PG8_WAIT_V
#undef PG8_WAIT_L
#undef PG8_BAR
#undef PG8_SCHED
}
}
#endif
#ifndef EMU_HOST
#define SCHED_FENCE() __builtin_amdgcn_sched_barrier(0)
#define OPAQUE(v) asm volatile("" : "+v"(v))
#define UNIFORM(x) __builtin_amdgcn_readfirstlane(x)
#define WAVE_ALL(p) (__all(p) != 0)
#else
#define SCHED_FENCE() do {} while (0)
#define OPAQUE(v) do {} while (0)
#define UNIFORM(x) (x)
#define WAVE_ALL(p) (p)
#endif
constexpr int HG_QM = 0, HG_KM = 17408, HG_KMT = 34816, HG_VT = 53248, HG_A = 71680, HG_VEC = 80896, HG_GSUM = 82432, HG_OSQ = 86528, HG_END = 88576;
static_assert(HG_END <= RING_BYTES, "HGRN LDS");

template <bool FULL>
DEV void hgrn_unit(LAS unsigned char* lds, int tid, const bf16_t* zq, const bf16_t* zg, const bf16_t* zv, const bf16_t* zgate, const float* gout, bf16_t* ob,
                   int rowbase, int nchunks, int h, const float* s_init, float* s_out, float* gseg_out) {
    OPAQUE(tid);
    const int lane = tid & 63, w = UNIFORM(tid >> 6), l16 = lane & 15, q4 = lane >> 4, kp = tid & 63, tg = w;
    f32x4 S[8];
#pragma unroll
    for (int kb = 0; kb < 8; ++kb)
#pragma unroll
        for (int r = 0; r < 4; ++r) S[kb][r] = s_init ? s_init[(size_t)(16 * kb + 4 * q4 + r) * HD + 16 * w + l16] : 0.f;
    unsigned pq[8], pg[8], pv[8];
    const size_t colq = (size_t)h * HD + 2 * kp;
#pragma unroll
    for (int i = 0; i < 8; ++i) { const size_t o = (size_t)(rowbase + 8 * tg + i) * D + colq; pg[i] = *(const unsigned*)(zg + o); pv[i] = *(const unsigned*)(zv + o); if (FULL) pq[i] = *(const unsigned*)(zq + o); }
    float gs0 = 0.f, gs1 = 0.f;
    for (int c = 0; c < nchunks; ++c) {
        float G0[8], G1[8], g0[8], g1[8];
        { float c0 = 0.f, c1 = 0.f;
#pragma unroll
          for (int i = 0; i < 8; ++i) { g0[i] = h_lo(pg[i]); g1[i] = h_hi(pg[i]); c0 += g0[i]; c1 += g1[i]; G0[i] = c0; G1[i] = c1; }
          *(LAS f32x2*)(lds + HG_GSUM + (tg * 128 + 2 * kp) * 4) = (f32x2){c0, c1}; }
        BLOCK_SYNC();
        float P0 = 0.f, P1 = 0.f, T0 = 0.f, T1 = 0.f, M0 = 0.f, M1 = 0.f;
#pragma unroll
        for (int j = 0; j < 8; ++j) { const f32x2 s = *(const LAS f32x2*)(lds + HG_GSUM + (j * 128 + 2 * kp) * 4); if (j < tg) { P0 += s.x; P1 += s.y; } if (j < 4) { M0 += s.x; M1 += s.y; } T0 += s.x; T1 += s.y; }
        unsigned kmw[8];
#pragma unroll
        for (int i = 0; i < 8; ++i) { const int t = 8 * tg + i; const float Gt0 = P0 + G0[i], Gt1 = P1 + G1[i];
            const float ek0 = fexp(fminf(M0 - Gt0, 80.f)), ek1 = fexp(fminf(M1 - Gt1, 80.f));
            kmw[i] = pk2((1.f - fexp(g0[i])) * ek0, (1.f - fexp(g1[i])) * ek1);
            if (FULL) { const float eq0 = fexp(fminf(Gt0 - M0, 80.f)), eq1 = fexp(fminf(Gt1 - M1, 80.f));
                *(LAS unsigned*)(lds + HG_QM + t * 272 + 4 * kp) = pk2(bf_lo(pq[i]) * eq0, bf_hi(pq[i]) * eq1);
                *(LAS unsigned*)(lds + HG_KM + t * 272 + 4 * kp) = kmw[i]; } }
        { u32x4 a, b;
          a.x = (kmw[0] & 0xffffu) | (kmw[1] << 16); a.y = (kmw[2] & 0xffffu) | (kmw[3] << 16); a.z = (kmw[4] & 0xffffu) | (kmw[5] << 16); a.w = (kmw[6] & 0xffffu) | (kmw[7] << 16);
          b.x = (kmw[0] >> 16) | (kmw[1] & 0xffff0000u); b.y = (kmw[2] >> 16) | (kmw[3] & 0xffff0000u); b.z = (kmw[4] >> 16) | (kmw[5] & 0xffff0000u); b.w = (kmw[6] >> 16) | (kmw[7] & 0xffff0000u);
          *(LAS u32x4*)(lds + HG_KMT + (2 * kp) * 144 + tg * 16) = a; *(LAS u32x4*)(lds + HG_KMT + (2 * kp + 1) * 144 + tg * 16) = b;
          a.x = (pv[0] & 0xffffu) | (pv[1] << 16); a.y = (pv[2] & 0xffffu) | (pv[3] << 16); a.z = (pv[4] & 0xffffu) | (pv[5] << 16); a.w = (pv[6] & 0xffffu) | (pv[7] << 16);
          b.x = (pv[0] >> 16) | (pv[1] & 0xffff0000u); b.y = (pv[2] >> 16) | (pv[3] & 0xffff0000u); b.z = (pv[4] >> 16) | (pv[5] & 0xffff0000u); b.w = (pv[6] >> 16) | (pv[7] & 0xffff0000u);
          *(LAS u32x4*)(lds + HG_VT + (2 * kp) * 144 + tg * 16) = a; *(LAS u32x4*)(lds + HG_VT + (2 * kp + 1) * 144 + tg * 16) = b; }
        if (tg == 0) { LAS float* vec = (LAS float*)(lds + HG_VEC);
            *(LAS f32x2*)(vec + 2 * kp) = (f32x2){fexp(M0), fexp(M1)}; *(LAS f32x2*)(vec + 128 + 2 * kp) = (f32x2){fexp(T0), fexp(T1)}; *(LAS f32x2*)(vec + 256 + 2 * kp) = (f32x2){fexp(T0 - M0), fexp(T1 - M1)};
            gs0 += T0; gs1 += T1; }
        if (c + 1 < nchunks) {
#pragma unroll
            for (int i = 0; i < 8; ++i) { const size_t o = (size_t)(rowbase + (c + 1) * CH + 8 * tg + i) * D + colq; pg[i] = *(const unsigned*)(zg + o); pv[i] = *(const unsigned*)(zv + o); if (FULL) pq[i] = *(const unsigned*)(zq + o); } }
        BLOCK_SYNC();
        if (FULL) { const int tb = w & 3;
#pragma unroll
            for (int sbi = 0; sbi < 2; ++sbi) { const int sb = 2 * (w >> 2) + sbi;
                if (sb <= tb) { f32x4 acc = {0.f, 0.f, 0.f, 0.f};
#pragma unroll
                    for (int st = 0; st < 4; ++st) { const bf16x8 a = *(const LAS bf16x8*)(lds + HG_KM + (16 * sb + l16) * 272 + (32 * st + 8 * q4) * 2), b = *(const LAS bf16x8*)(lds + HG_QM + (16 * tb + l16) * 272 + (32 * st + 8 * q4) * 2);
                        acc = MFMA16(a, b, acc); }
                    if (sb == tb) {
#pragma unroll
                        for (int r = 0; r < 4; ++r) if (4 * q4 + r > l16) acc[r] = 0.f; }
                    *(LAS u32x2*)(lds + HG_A + (16 * tb + l16) * 144 + (16 * sb + 4 * q4) * 2) = (u32x2){pk2(acc[0], acc[1]), pk2(acc[2], acc[3])};
                } else if ((sb >> 1) <= (tb >> 1)) *(LAS u32x2*)(lds + HG_A + (16 * tb + l16) * 144 + (16 * sb + 4 * q4) * 2) = (u32x2){0u, 0u};
            }
            BLOCK_SYNC(); }
        const LAS float* vec = (const LAS float*)(lds + HG_VEC);
        bf16x8 vtf[2];
#pragma unroll
        for (int ss = 0; ss < 2; ++ss) vtf[ss] = *(const LAS bf16x8*)(lds + HG_VT + (16 * w + l16) * 144 + (32 * ss + 8 * q4) * 2);
        f32x4 o[4];
        if (FULL) {
            bf16x8 bfr[4];
#pragma unroll
            for (int j = 0; j < 4; ++j) { const f32x4 e0 = *(const LAS f32x4*)(vec + 32 * j + 4 * q4), e1 = *(const LAS f32x4*)(vec + 32 * j + 16 + 4 * q4);
                u32x4 t; t.x = pk2(S[2 * j][0] * e0[0], S[2 * j][1] * e0[1]); t.y = pk2(S[2 * j][2] * e0[2], S[2 * j][3] * e0[3]); t.z = pk2(S[2 * j + 1][0] * e1[0], S[2 * j + 1][1] * e1[1]); t.w = pk2(S[2 * j + 1][2] * e1[2], S[2 * j + 1][3] * e1[3]);
                bfr[j] = __builtin_bit_cast(bf16x8, t); }
#pragma unroll
            for (int tb = 0; tb < 4; ++tb) { f32x4 acc = {0.f, 0.f, 0.f, 0.f};
#pragma unroll
                for (int j = 0; j < 4; ++j) { const u32x2 a0 = *(const LAS u32x2*)(lds + HG_QM + (16 * tb + l16) * 272 + (32 * j + 4 * q4) * 2), a1 = *(const LAS u32x2*)(lds + HG_QM + (16 * tb + l16) * 272 + (32 * j + 16 + 4 * q4) * 2);
                    const u32x4 t = {a0.x, a0.y, a1.x, a1.y}; acc = MFMA16(__builtin_bit_cast(bf16x8, t), bfr[j], acc); }
#pragma unroll
                for (int ss = 0; ss < 2; ++ss) if (ss == 0 || tb >= 2) { const bf16x8 a = *(const LAS bf16x8*)(lds + HG_A + (16 * tb + l16) * 144 + (32 * ss + 8 * q4) * 2); acc = MFMA16(a, vtf[ss], acc); }
                o[tb] = acc; SCHED_FENCE(); }
        }
#pragma unroll
        for (int kb = 0; kb < 8; ++kb) { f32x4 u = {0.f, 0.f, 0.f, 0.f};
#pragma unroll
            for (int ss = 0; ss < 2; ++ss) { const bf16x8 a = *(const LAS bf16x8*)(lds + HG_KMT + (16 * kb + l16) * 144 + (32 * ss + 8 * q4) * 2); u = MFMA16(a, vtf[ss], u); }
            const f32x4 av = *(const LAS f32x4*)(vec + 128 + 16 * kb + 4 * q4), bv = *(const LAS f32x4*)(vec + 256 + 16 * kb + 4 * q4);
#pragma unroll
            for (int r = 0; r < 4; ++r) S[kb][r] = av[r] * S[kb][r] + bv[r] * u[r]; SCHED_FENCE(); }
        if (FULL) {
#pragma unroll
            for (int tb = 0; tb < 4; ++tb)
#pragma unroll
                for (int r = 0; r < 4; ++r) { float sq = o[tb][r] * o[tb][r]; sq += SHFL_XOR(sq, 1); sq += SHFL_XOR(sq, 2); sq += SHFL_XOR(sq, 4); sq += SHFL_XOR(sq, 8);
                    if (l16 == 0) *(LAS float*)(lds + HG_OSQ + ((16 * tb + 4 * q4 + r) * 8 + w) * 4) = sq; }
            BLOCK_SYNC();
            const int col = h * HD + 16 * w + l16; const float gv = gout[col];
#pragma unroll
            for (int tb = 0; tb < 4; ++tb)
#pragma unroll
                for (int r = 0; r < 4; ++r) { const int t = 16 * tb + 4 * q4 + r; const f32x4 s0 = *(const LAS f32x4*)(lds + HG_OSQ + t * 32), s1 = *(const LAS f32x4*)(lds + HG_OSQ + t * 32 + 16);
                    const float tot = ((s0[0] + s0[1]) + (s0[2] + s0[3])) + ((s1[0] + s1[1]) + (s1[2] + s1[3])); const float rstd = frsq(tot * (1.0f / HD) + EPS);
                    const size_t oo = (size_t)(rowbase + c * CH + t) * D + col;
                    ob[oo] = (bf16_t)(pk2(o[tb][r] * rstd * gv * bf2f(zgate[oo]), 0.f) & 0xffffu); }
        }
    }
    if (s_out) {
#pragma unroll
        for (int kb = 0; kb < 8; ++kb)
#pragma unroll
            for (int r = 0; r < 4; ++r) s_out[(size_t)(16 * kb + 4 * q4 + r) * HD + 16 * w + l16] = S[kb][r]; }
    if (gseg_out && tg == 0) { gseg_out[2 * kp] = gs0; gseg_out[2 * kp + 1] = gs1; }
    BLOCK_SYNC();
}

DEV void hgrn_scan(int gtid, int GT, const float* lseg, const float* gseg, float* sstart) {
    OPAQUE(gtid);
    for (int e = gtid; e < 32 * HD * HD; e += GT) { const int stream = e >> 14, kv = e & 16383, k = kv >> 7; float s = 0.f;
        for (int j = 0; j < NSEG - 1; ++j) { const size_t sj = (size_t)stream * NSEG + j; s = fexp(gseg[sj * HD + k]) * s + lseg[(sj << 14) + kv]; sstart[((sj + 1) << 14) + kv] = s; } }
}

template <int PT>
DEV void cumsum_unit(LAS unsigned char* lds, int tid, const float* a, int na, int sa, const float* b, int sb, int n, float* dst) {
    OPAQUE(tid);
    LAS double* part = (LAS double*)lds; LAS double* grp = part + 512;
    float v[PT]; double loc = 0.0;
#pragma unroll
    for (int i = 0; i < PT; ++i) { const int p = tid * PT + i; v[i] = p < n ? (p < na ? a[(size_t)p * sa] : b[(size_t)(p - na) * sb]) : 0.f; loc += (double)v[i]; }
    part[tid] = loc;
    BLOCK_SYNC();
    double pre = 0.0; const int g0 = tid & ~15;
    for (int j = g0; j < tid; ++j) pre += part[j];
    if ((tid & 15) == 15) grp[tid >> 4] = pre + loc;
    BLOCK_SYNC();
    for (int j = 0; j < (tid >> 4); ++j) pre += grp[j];
#pragma unroll
    for (int i = 0; i < PT; ++i) { const int p = tid * PT + i; pre += (double)v[i]; if (p < n) dst[p] = (float)pre; }
    BLOCK_SYNC();
}

DEV void knorm_unit(int tid, const bf16_t* Kb, int nkeys, unsigned* dst) {
    OPAQUE(tid);
    const int sub = tid & 15, kr = tid >> 4; float mx = 0.f;
    for (int k0 = 0; k0 < nkeys; k0 += 32) { const u32x4 t = *(const u32x4*)(Kb + (size_t)(k0 + kr) * D + sub * 8); float s = 0.f;
#pragma unroll
        for (int e = 0; e < 4; ++e) { const float a = bf_lo(t[e]), b = bf_hi(t[e]); s += a * a + b * b; }
        s += SHFL_XOR(s, 1); s += SHFL_XOR(s, 2); s += SHFL_XOR(s, 4); s += SHFL_XOR(s, 8); mx = fmaxf(mx, s); }
    mx = fmaxf(mx, SHFL_XOR(mx, 16)); mx = fmaxf(mx, SHFL_XOR(mx, 32));
    if ((tid & 63) == 0) ATOMIC_MAX_U32(dst, __builtin_bit_cast(unsigned, mx));
}

constexpr int AT_K = 0, AT_VT = 17408, AT_DK = 35840, AT_FLAG = 36096, AT_END = 36160;
constexpr float PRUNE_T2 = 36.0f;
DEV void attn_block(LAS unsigned char* lds, int tid, const bf16_t* Q, const bf16_t* gate, bf16_t* O, const bf16_t* Kb, const bf16_t* Vb, const float* Dc, int qpos0, int nrows, float kmax) {
    OPAQUE(tid);
    const int lane = tid & 63, w = UNIFORM(tid >> 6), l16 = lane & 15, q4 = lane >> 4, dp = tid & 63, kg = w;
    const bool active = 32 * w < nrows;
    const int ntiles = (qpos0 + nrows + 63) >> 6;
    constexpr float C2 = 0.08838834764831845f * LOG2E;
    bf16x8 Qf[2][4]; float Dq2[2], mrun[2], lrun[2], cb[2]; f32x4 Oa[2][8];
#pragma unroll
    for (int qb = 0; qb < 2; ++qb) { const int r = active ? 32 * w + 16 * qb + l16 : 0;
#pragma unroll
        for (int st = 0; st < 4; ++st) Qf[qb][st] = *(const bf16x8*)(Q + (size_t)r * D + 32 * st + 8 * q4);
        Dq2[qb] = Dc[qpos0 + r] * LOG2E; mrun[qb] = -1e30f; lrun[qb] = 0.f;
        { float q2 = 0.f;
#pragma unroll
          for (int st = 0; st < 4; ++st) { const u32x4 t = __builtin_bit_cast(u32x4, Qf[qb][st]);
#pragma unroll
              for (int e = 0; e < 4; ++e) { const float a = bf_lo(t[e]), b = bf_hi(t[e]); q2 += a * a + b * b; } }
          q2 += SHFL_XOR(q2, 16); q2 += SHFL_XOR(q2, 32); cb[qb] = sqrtf(q2) * kmax * C2 + Dq2[qb]; }
#pragma unroll
        for (int db = 0; db < 8; ++db) Oa[qb][db] = (f32x4){0.f, 0.f, 0.f, 0.f}; }
    u32x4 pk_[2]; unsigned pv[8]; float pd = 0.f;
    const int krow = tid >> 4, kc16 = tid & 15;
#define AT_LOAD(j) do { _Pragma("unroll") for (int i = 0; i < 2; ++i) pk_[i] = *(const u32x4*)(Kb + (size_t)(64 * (j) + krow + 32 * i) * D + kc16 * 8); \
        _Pragma("unroll") for (int i = 0; i < 8; ++i) pv[i] = *(const unsigned*)(Vb + (size_t)(64 * (j) + 8 * kg + i) * D + 2 * dp); \
        if (tid < 64) pd = Dc[64 * (j) + tid] * LOG2E; } while (0)
    AT_LOAD(ntiles - 1);
    const int ks_ = kg >> 2, kq = kg & 3, hb = kq >> 1;
    const int vpos0 = (32 * ks_ + 16 * (kq & 1) + 4 * hb) * 2, vpos1 = vpos0 + 16;
    if (tid < 8) *(LAS unsigned*)(lds + AT_FLAG + tid * 4) = 0u;
    for (int j = ntiles - 1; j >= 0; --j) {
        BLOCK_SYNC();
        { const u32x4 f0 = *(const LAS u32x4*)(lds + AT_FLAG), f1 = *(const LAS u32x4*)(lds + AT_FLAG + 16);
          if (UNIFORM((f0.x & f0.y & f0.z & f0.w & f1.x & f1.y & f1.z & f1.w) != 0u)) break; }
#pragma unroll
        for (int i = 0; i < 2; ++i) *(LAS u32x4*)(lds + AT_K + (krow + 32 * i) * 272 + kc16 * 16) = pk_[i];
        { u32x2 a, b;
          a.x = (pv[0] & 0xffffu) | (pv[1] << 16); a.y = (pv[2] & 0xffffu) | (pv[3] << 16); b.x = (pv[4] & 0xffffu) | (pv[5] << 16); b.y = (pv[6] & 0xffffu) | (pv[7] << 16);
          *(LAS u32x2*)(lds + AT_VT + (2 * dp) * 144 + vpos0) = a; *(LAS u32x2*)(lds + AT_VT + (2 * dp) * 144 + vpos1) = b;
          a.x = (pv[0] >> 16) | (pv[1] & 0xffff0000u); a.y = (pv[2] >> 16) | (pv[3] & 0xffff0000u); b.x = (pv[4] >> 16) | (pv[5] & 0xffff0000u); b.y = (pv[6] >> 16) | (pv[7] & 0xffff0000u);
          *(LAS u32x2*)(lds + AT_VT + (2 * dp + 1) * 144 + vpos0) = a; *(LAS u32x2*)(lds + AT_VT + (2 * dp + 1) * 144 + vpos1) = b; }
        if (tid < 64) *(LAS float*)(lds + AT_DK + tid * 4) = pd;
        BLOCK_SYNC();
        if (j > 0) AT_LOAD(j - 1);
        bool done = true;
        if (active && 64 * j <= qpos0 + 32 * w + 31) {
            f32x4 s[2][4];
#pragma unroll
            for (int kb = 0; kb < 4; ++kb) { bf16x8 kf[4];
#pragma unroll
                for (int st = 0; st < 4; ++st) kf[st] = *(const LAS bf16x8*)(lds + AT_K + (16 * kb + l16) * 272 + (32 * st + 8 * q4) * 2);
#pragma unroll
                for (int qb = 0; qb < 2; ++qb) { f32x4 acc = {0.f, 0.f, 0.f, 0.f};
#pragma unroll
                    for (int st = 0; st < 4; ++st) acc = MFMA16(kf[st], Qf[qb][st], acc);
                    s[qb][kb] = acc; } SCHED_FENCE(); }
            const bool need_mask = 64 * j + 63 > qpos0 + 32 * w;
#pragma unroll
            for (int qb = 0; qb < 2; ++qb) { const int qpos = qpos0 + 32 * w + 16 * qb + l16; float mx = -__builtin_inff();
#pragma unroll
                for (int kb = 0; kb < 4; ++kb) { const f32x4 dk = *(const LAS f32x4*)(lds + AT_DK + (16 * kb + 4 * q4) * 4);
#pragma unroll
                    for (int r = 0; r < 4; ++r) { float v = s[qb][kb][r] * C2 + (Dq2[qb] - dk[r]); if (need_mask && 64 * j + 16 * kb + 4 * q4 + r > qpos) v = -__builtin_inff(); s[qb][kb][r] = v; mx = fmaxf(mx, v); } }
                mx = fmaxf(mx, SHFL_XOR(mx, 16)); mx = fmaxf(mx, SHFL_XOR(mx, 32));
                const float mn = fmaxf(mrun[qb], mx), alpha = fexp2(mrun[qb] - mn); mrun[qb] = mn; float ps = 0.f;
#pragma unroll
                for (int kb = 0; kb < 4; ++kb)
#pragma unroll
                    for (int r = 0; r < 4; ++r) { const float p = fexp2(s[qb][kb][r] - mn); s[qb][kb][r] = p; ps += p; }
                lrun[qb] = lrun[qb] * alpha + ps;
#pragma unroll
                for (int db = 0; db < 8; ++db) Oa[qb][db] = Oa[qb][db] * alpha; }
            bf16x8 pf[2][2];
#pragma unroll
            for (int qb = 0; qb < 2; ++qb)
#pragma unroll
                for (int ks = 0; ks < 2; ++ks) { u32x4 t; t.x = pk2(s[qb][2 * ks][0], s[qb][2 * ks][1]); t.y = pk2(s[qb][2 * ks][2], s[qb][2 * ks][3]); t.z = pk2(s[qb][2 * ks + 1][0], s[qb][2 * ks + 1][1]); t.w = pk2(s[qb][2 * ks + 1][2], s[qb][2 * ks + 1][3]);
                    pf[qb][ks] = __builtin_bit_cast(bf16x8, t); }
#pragma unroll
            for (int db = 0; db < 8; ++db)
#pragma unroll
                for (int ks = 0; ks < 2; ++ks) { const bf16x8 a = *(const LAS bf16x8*)(lds + AT_VT + (16 * db + l16) * 144 + (32 * ks + 8 * q4) * 2);
#pragma unroll
                    for (int qb = 0; qb < 2; ++qb) Oa[qb][db] = MFMA16(a, pf[qb][ks], Oa[qb][db]); if (ks == 1) SCHED_FENCE(); }
        }
        if (active) { const float dk0 = *(const LAS float*)(lds + AT_DK);
            done = (cb[0] - dk0 - mrun[0] < -PRUNE_T2) && (cb[1] - dk0 - mrun[1] < -PRUNE_T2); }
        { const bool wdone = WAVE_ALL(done); if (lane == 0) *(LAS unsigned*)(lds + AT_FLAG + w * 4) = wdone ? 1u : 0u; }
    }
#undef AT_LOAD
    if (active) {
#pragma unroll
        for (int qb = 0; qb < 2; ++qb) { float l = lrun[qb]; l += SHFL_XOR(l, 16); l += SHFL_XOR(l, 32); const float inv = 1.0f / l; const size_t ro = (size_t)(32 * w + 16 * qb + l16) * D;
#pragma unroll
            for (int db = 0; db < 8; ++db) { const u32x2 gt = *(const u32x2*)(gate + ro + 16 * db + 4 * q4); const f32x4 ov = Oa[qb][db] * inv;
                *(u32x2*)(O + ro + 16 * db + 4 * q4) = (u32x2){pk2(ov[0] * bf_lo(gt.x), ov[1] * bf_hi(gt.x)), pk2(ov[2] * bf_lo(gt.y), ov[3] * bf_hi(gt.y))}; } }
    }
    BLOCK_SYNC();
}
#ifndef EMU_HOST
#define RLX_AGENT __ATOMIC_RELAXED, __HIP_MEMORY_SCOPE_AGENT
#define LDS_WAIT() asm volatile("s_waitcnt lgkmcnt(0)" ::: "memory")
typedef GAS unsigned gu32;
#define XB_TMO      128
#define XB_XCNT(j)  (256  + 64 * (j))
#define XB_XSUB(j)  (1280 + 64 * (j))
#define XB_XGEN(j)  (2304 + 64 * (j))
#define XB_TOP      3328
#define XB_TOPGEN   3392
#define XCD_BAR_WORDS 3456
#define XB_SPIN_CAP (1u << 18)

__device__ __forceinline__ unsigned xb_ld(unsigned* p)              { return __hip_atomic_load(p, __ATOMIC_RELAXED, __HIP_MEMORY_SCOPE_AGENT); }
__device__ __forceinline__ unsigned xb_add(unsigned* p, unsigned v) { return __hip_atomic_fetch_add(p, v, __ATOMIC_RELAXED, __HIP_MEMORY_SCOPE_AGENT); }
__device__ __forceinline__ unsigned xb_xcc_id() { return (unsigned)__builtin_amdgcn_s_getreg((3 << 11) | 20) & 0xFu; }
#define XB_SPIN(cond, bar) do { unsigned _sp = 0; while (cond) { __builtin_amdgcn_s_sleep(1); \
    if ((++_sp & 255u) == 0u) { if (xb_ld(&(bar)[XB_TMO])) break; if (_sp > XB_SPIN_CAP) { atomicAdd(&(bar)[XB_TMO], 1u); break; } } } } while (0)

struct XcdBarrier {
    unsigned* bar; unsigned x;
    volatile LAS unsigned* st;
};

__device__ __forceinline__ XcdBarrier xcd_barrier_post(unsigned* bar, volatile LAS unsigned* st) {
    XcdBarrier b; b.bar = bar; b.x = xb_xcc_id(); b.st = st;
    if (threadIdx.x == 0) (void)xb_add(&bar[XB_XCNT(b.x)], 1u);
    return b;
}
__device__ __forceinline__ void xcd_barrier_complete(unsigned* bar, unsigned x, unsigned& nloc, unsigned& nx) {
    const unsigned G = gridDim.x * gridDim.y * gridDim.z;
    unsigned sum, cnt, mine, sp = 0u;
    for (;;) {
        sum = 0u; cnt = 0u; mine = 0u;
#pragma unroll
        for (unsigned j = 0; j < 16; ++j) { const unsigned c = xb_ld(&bar[XB_XCNT(j)]); sum += c; cnt += (c > 0u) ? 1u : 0u; mine = (j == x) ? c : mine; }
        if (sum == G) break;
        __builtin_amdgcn_s_sleep(1);
        if ((++sp & 255u) == 0u) { if (xb_ld(&bar[XB_TMO])) break; if (sp > XB_SPIN_CAP) { atomicAdd(&bar[XB_TMO], 1u); break; } }
    }
    nloc = mine > 0u ? mine : 1u; nx = cnt > 0u ? cnt : 1u;
}

__device__ __forceinline__ void xcd_barrier(const XcdBarrier& b) {
    asm volatile("s_waitcnt vmcnt(0)" ::: "memory");
    __syncthreads();
    if (threadIdx.x == 0) {
        unsigned* bar = b.bar;
        __builtin_amdgcn_s_waitcnt(0);
        unsigned nloc = b.st[0], nx = b.st[1];
        if (nloc == 0u) { xcd_barrier_complete(bar, b.x, nloc, nx); b.st[0] = nloc; b.st[1] = nx; }
        const unsigned old = xb_add(&bar[XB_XSUB(b.x)], 1u);
        const unsigned gen = old / nloc;
        if (old + 1u == (gen + 1u) * nloc) {
            __builtin_amdgcn_fence(__ATOMIC_RELEASE, "agent");
            asm volatile("s_waitcnt vmcnt(0)" ::: "memory");
            const unsigned og = xb_add(&bar[XB_TOP], 1u);
            const unsigned tg = og / nx;
            if (og + 1u == (tg + 1u) * nx) xb_add(&bar[XB_TOPGEN], 1u);
            else XB_SPIN(xb_ld(&bar[XB_TOPGEN]) == tg, bar);
            __builtin_amdgcn_fence(__ATOMIC_ACQUIRE, "agent");
            xb_add(&bar[XB_XGEN(b.x)], 1u);
            asm volatile("s_waitcnt vmcnt(0)" ::: "memory");
        } else {
            XB_SPIN(xb_ld(&bar[XB_XGEN(b.x)]) == gen, bar);
            __builtin_amdgcn_fence(__ATOMIC_ACQUIRE, "agent");
            asm volatile("s_waitcnt vmcnt(0)" ::: "memory");
        }
    }
    __syncthreads();
}


__device__ __forceinline__ void p0_transpose_item(const float* W, int K, int N, int pitch, const float* gain, bf16_t* WT, int row_off, LAS float* scr, int item, int lane) {
    const int nblk = N / 32, kb = item / nblk, nb = item % nblk, k0 = 64 * kb, n0 = 32 * nb;
#pragma unroll 8
    for (int i = 0; i < 32; ++i) { const int kk = 2 * i + (lane >> 5); const float gk = gain ? gain[k0 + kk] : 1.0f; scr[kk * 33 + (lane & 31)] = W[(size_t)(k0 + kk) * pitch + n0 + (lane & 31)] * gk; }
    LDS_WAIT(); asm volatile("" ::: "memory");
    const int c = lane & 7;
#pragma unroll
    for (int j = 0; j < 4; ++j) { const int n = (lane >> 3) + 8 * j; const LAS float* s = scr + (8 * c) * 33 + n;
        u32x4 o; o.x = pk2(s[0 * 33], s[1 * 33]); o.y = pk2(s[2 * 33], s[3 * 33]); o.z = pk2(s[4 * 33], s[5 * 33]); o.w = pk2(s[6 * 33], s[7 * 33]);
        *(u32x4*)(WT + (size_t)(row_off + n0 + n) * K + k0 + 8 * c) = o; }
    LDS_WAIT(); asm volatile("" ::: "memory");
}
__device__ __forceinline__ float wave_sum(float v) {
#pragma unroll
    for (int o = 1; o < 64; o <<= 1) v += __shfl_xor(v, o);
    return v;
}

#ifndef SITES
#define SITES 0xFFFF
#endif
#define SITE(k) ((SITES >> (k)) & 1)
struct Args { const float* in[23]; float* out; unsigned char* ws; int ph_lo, ph_hi; };
constexpr int N_PHASES = 26;
__host__ __device__ constexpr bool phase_nonempty(int p) { return !(p == 15 || p == 20 || p == 21); }

__global__ void __launch_bounds__(NWAVES * 64, 2) fwd(Args args) {
    extern __shared__ __attribute__((aligned(16))) unsigned char lds_raw[];
    LAS unsigned char* lds = (LAS unsigned char*)lds_raw;
    volatile LAS unsigned* MISC = (volatile LAS unsigned*)(lds + MISC_OFF);
    const int wave0 = __builtin_amdgcn_readfirstlane(threadIdx.x >> 6);
    const int G = gridDim.x, bx = blockIdx.x, vcu = (G % 8 == 0) ? (bx % 8) * (G / 8) + bx / 8 : bx;
    gu32* ctl = (gu32*)(args.ws + WS_CTL);
    for (int u = threadIdx.x; u < (LDS_BYTES - LDSCTL_OFF) / 4; u += NWAVES * 64) ((LAS unsigned*)(lds + LDSCTL_OFF))[u] = 0u;
    __syncthreads();
    const bool one_launch = (args.ph_lo == 0 && args.ph_hi == N_PHASES);
    XcdBarrier bar; bar.bar = (unsigned*)(ctl + CW_BAR); bar.x = 0; bar.st = nullptr;
    if (one_launch) bar = xcd_barrier_post((unsigned*)(ctl + CW_BAR), MISC + 8);
    const int lo = args.ph_lo, hi = args.ph_hi;
#define IN(k) (lo <= (k) && (k) < hi)
#define SEAM(k) do { if ((k) + 1 < hi) xcd_barrier(bar); } while (0)
#define SITE_FRAME() int tid; asm volatile("v_mbcnt_lo_u32_b32 %0, -1, 0\n\tv_mbcnt_hi_u32_b32 %0, -1, %0" : "=v"(tid)); tid += wave0 * 64; GAS unsigned char* wsb = (GAS unsigned char*)args.ws; asm volatile("" : "+s"(wsb)); \
    const int lane = tid & 63, wave = wave0, gw = vcu * NWAVES + wave, NGW = G * NWAVES, gtid = vcu * (NWAVES * 64) + tid, GT = G * NWAVES * 64; \
    (void)lane; (void)wave; (void)gw; (void)NGW; (void)gtid; (void)GT; (void)wsb
#define x_prompt (args.in[0])
#define x_sample (args.in[1])
#define state_hgrn (args.in[2])
#define cache_k (args.in[3])
#define cache_v (args.in[4])
#define cache_logf (args.in[5])
#define p_prompt (args.in[6])
#define p_sample (args.in[7])
#define g_norm_a (args.in[8])
#define w_in_a (args.in[9])
#define lb_logits (args.in[10])
#define g_out_a (args.in[11])
#define w_out_a (args.in[12])
#define g_kv (args.in[13])
#define w_kv (args.in[14])
#define b_f (args.in[15])
#define g_norm_b (args.in[16])
#define w_in_b (args.in[17])
#define w_out_b (args.in[18])
#define w_ple_in (args.in[19])
#define g_ple (args.in[20])
#define w_ple_gate (args.in[21])
#define g_final (args.in[22])
#define ss ((float*)(wsb + WS_SS))
#define lbv ((float*)(wsb + WS_LBV))
#define gseg ((float*)(wsb + WS_GSEG))
#define Dp ((float*)(wsb + WS_DP))
#define Ds ((float*)(wsb + WS_DS))
#define LF ((float*)(wsb + WS_LF))
#define W_AIN ((bf16_t*)(wsb + WS_WAIN))
#define W_AOUT ((bf16_t*)(wsb + WS_WAOUT))
#define W_KVQ ((bf16_t*)(wsb + WS_WKVQ))
#define W_BIN1 ((bf16_t*)(wsb + WS_WBIN1))
#define W_BOUT ((bf16_t*)(wsb + WS_WBOUT))
#define W_PIN ((bf16_t*)(wsb + WS_WPIN))
#define W_PG ((bf16_t*)(wsb + WS_WPG))
#define X ((float*)(wsb + WS_X))
#define XB ((bf16_t*)(wsb + WS_XB))
#define XB2 ((bf16_t*)(wsb + WS_XB2))
#define ZQ ((bf16_t*)(wsb + WS_ZQ))
#define ZG ((bf16_t*)(wsb + WS_ZG))
#define ZV ((bf16_t*)(wsb + WS_ZV))
#define ZGATE ((bf16_t*)(wsb + WS_ZGATE))
#define OB ((bf16_t*)(wsb + WS_OB))
#define EB ((bf16_t*)(wsb + WS_EB))
#define PB ((bf16_t*)(wsb + WS_PB))
#define KS ((bf16_t*)(wsb + WS_KS))
#define VS ((bf16_t*)(wsb + WS_VS))
#define KP ((bf16_t*)(wsb + WS_KP))
#define VP ((bf16_t*)(wsb + WS_VP))
#define LSEG ((float*)(wsb + WS_LSEG))
#define SSTART ((float*)(wsb + WS_SSTART))
#define out (args.out)
    if (SITE(10) && IN(0)) { SITE_FRAME();
        LAS float* scr = (LAS float*)(lds + wave * 16384);
        constexpr int I_AIN = 32 * 256, I_SQ = 32 * 64, I_KV = 32 * 128, I_PIN = 4 * 64;
        constexpr int NITEMS = 2 * I_AIN + 2 * I_SQ + 3 * I_KV + 2 * I_SQ + 4 * I_PIN + 4 * I_SQ;
        for (int it = gw; it < NITEMS; it += NGW) {
            int r = it;
            if (r < 2 * I_AIN) { const int l = r / I_AIN; p0_transpose_item(w_in_a + (size_t)l * D * 4 * D, D, 4 * D, 4 * D, g_norm_a + l * D, W_AIN + (size_t)l * 4 * D * D, 0, scr, r % I_AIN, lane); continue; } r -= 2 * I_AIN;
            if (r < 2 * I_SQ) { const int l = r / I_SQ; p0_transpose_item(w_out_a + (size_t)l * D * D, D, D, D, nullptr, W_AOUT + (size_t)l * D * D, 0, scr, r % I_SQ, lane); continue; } r -= 2 * I_SQ;
            if (r < I_KV) { p0_transpose_item(w_kv, D, 2 * D, 2 * D + H, g_kv, W_KVQ, 0, scr, r, lane); continue; } r -= I_KV;
            if (r < I_KV) { p0_transpose_item(w_in_b, D, 2 * D, 2 * D, g_norm_b, W_KVQ, 2 * D, scr, r, lane); continue; } r -= I_KV;
            if (r < I_KV) { p0_transpose_item(w_in_b + (size_t)D * 2 * D, D, 2 * D, 2 * D, g_norm_b + D, W_BIN1, 0, scr, r, lane); continue; } r -= I_KV;
            if (r < 2 * I_SQ) { const int l = r / I_SQ; p0_transpose_item(w_out_b + (size_t)l * D * D, D, D, D, nullptr, W_BOUT + (size_t)l * D * D, 0, scr, r % I_SQ, lane); continue; } r -= 2 * I_SQ;
            if (r < 4 * I_PIN) { const int l = r / I_PIN; p0_transpose_item(w_ple_in + (size_t)l * DPLE * D, DPLE, D, D, nullptr, W_PIN + (size_t)l * D * DPLE, 0, scr, r % I_PIN, lane); continue; } r -= 4 * I_PIN;
            { const int l = r / I_SQ; p0_transpose_item(w_ple_gate + (size_t)l * D * D, D, D, D, g_ple + l * D, W_PG + (size_t)l * D * D, 0, scr, r % I_SQ, lane); }
        }
        for (int e = gtid; e < 256 * D; e += GT) { const int n = e / D, k = e % D; W_KVQ[(size_t)(4 * D + n) * D + k] = n < H ? (bf16_t)(pk2(g_kv[k] * w_kv[(size_t)k * (2 * D + H) + 2 * D + n], 0.f) & 0xffffu) : (bf16_t)0; }
        for (int m = gw; m < M; m += NGW) { const float* xr = m < MP ? x_prompt + (size_t)m * D : x_sample + (size_t)(m - MP) * D; float s = 0.f;
#pragma unroll
            for (int j = 0; j < 8; ++j) { const f32x4 v = *(const f32x4*)(xr + 256 * j + 4 * lane); s += (v[0] * v[0] + v[1] * v[1]) + (v[2] * v[2] + v[3] * v[3]);
                *(u32x2*)(XB + (size_t)m * D + 256 * j + 4 * lane) = (u32x2){pk2(v[0], v[1]), pk2(v[2], v[3])}; }
            s = wave_sum(s); if (lane == 0) ss[m] = s; }
        for (size_t e = (size_t)gtid * 8; e < (size_t)4 * M * DPLE; e += (size_t)GT * 8) { const int l = (int)(e / ((size_t)M * DPLE)); const size_t r = e % ((size_t)M * DPLE); const int m = (int)(r / DPLE), c = (int)(r % DPLE);
            const float* src = m < MP ? p_prompt + ((size_t)l * MP + m) * DPLE + c : p_sample + ((size_t)l * MS + (m - MP)) * DPLE + c;
            const f32x4 a = *(const f32x4*)src, b = *(const f32x4*)(src + 4); *(u32x4*)(PB + e) = (u32x4){pk2(a[0], a[1]), pk2(a[2], a[3]), pk2(b[0], b[1]), pk2(b[2], b[3])}; }
        for (size_t e = (size_t)gtid * 8; e < (size_t)NBS * PAST * D; e += (size_t)GT * 8) { const size_t r = e / D; const int c = (int)(e % D); const size_t b = r / PAST, pos = r % PAST; const size_t d = (b * LKS + pos) * D + c;
            { const f32x4 a = *(const f32x4*)(cache_k + e), bb = *(const f32x4*)(cache_k + e + 4); *(u32x4*)(KS + d) = (u32x4){pk2(a[0], a[1]), pk2(a[2], a[3]), pk2(bb[0], bb[1]), pk2(bb[2], bb[3])}; }
            { const f32x4 a = *(const f32x4*)(cache_v + e), bb = *(const f32x4*)(cache_v + e + 4); *(u32x4*)(VS + d) = (u32x4){pk2(a[0], a[1]), pk2(a[2], a[3]), pk2(bb[0], bb[1]), pk2(bb[2], bb[3])}; } }
        for (int c = gtid; c < D; c += GT) { lbv[c] = 0.f; lbv[D + c] = 1.0f / (1.0f + expf(lb_logits[c] - lb_logits[D + c])); }
        SEAM(0);
    }

#pragma unroll 1
    for (int L = 0; L < 4; ++L) {
        const int pb = 1 + 6 * L; const bool isA = L < 2; const int j = L - 2;
        if (IN(pb)) { SITE_FRAME();
            if (SITE(0) && isA) { pg8::Gemm g{XB, W_AIN + (size_t)L * 4 * D * D, M, 4 * D, D}; pg8::StaticOrder S; S.init(M, 4 * D, G, bx);
                pg8::EpiAin E{ss + (size_t)(2 * L) * M, lbv + L * D, ZQ, ZG, ZV, ZGATE};
                pg8::gemm_phase<pg8::EpiAin, pg8::StaticOrder, true, true>(lds, g, S, E, wave0);
            } else if (SITE(1) && !isA) { const int N = (j == 0) ? NKVQ : 2 * D; pg8::Gemm g{XB, j == 0 ? W_KVQ : W_BIN1, M, N, D}; pg8::StaticOrder S; S.init(M, N, G, bx);
                pg8::EpiBin E{ss + (size_t)(2 * L) * M, j == 0 ? 0 : 2, KP, VP, KS, VS, ZQ, ZGATE, out, LF, b_f};
                pg8::gemm_phase<pg8::EpiBin, pg8::StaticOrder, true, true>(lds, g, S, E, wave0); }
            if (SITE(2)) { int kple = DPLE; asm volatile("" : "+s"(kple));
              pg8::Gemm g{PB + (size_t)L * M * DPLE, W_PIN + (size_t)L * D * DPLE, M, D, kple}; pg8::StaticOrder S; S.init(M, D, G, bx);
              pg8::EpiBf16 E{EB, D};
              pg8::gemm_phase<pg8::EpiBf16, pg8::StaticOrder, true, true>(lds, g, S, E, wave0); }
            SEAM(pb);
        }
        if (IN(pb + 1) && phase_nonempty(pb + 1)) { SITE_FRAME();
            if (SITE(3) && isA) {
                for (int u = vcu; u < 32 * (NSEG - 1); u += G) { const int stream = u / (NSEG - 1), seg = u % (NSEG - 1), b = stream >> 4, h = stream & 15;
                    hgrn_unit<false>(lds, tid, nullptr, ZG, ZV, nullptr, nullptr, nullptr, b * TP + seg * (SEGC * CH), SEGC, h, nullptr, LSEG + ((size_t)(stream * NSEG + seg) << 14), gseg + (size_t)(stream * NSEG + seg) * HD); }
            } else if (SITE(4) && !isA) {
                for (int u = vcu; u < 512 + 256; u += G) {
                    if (u < 512) { const int bh = u >> 4, c = u & 15, b = bh >> 4, h = bh & 15; knorm_unit(tid, KP + ((size_t)b * TP + c * 1024) * D + h * HD, 1024, (unsigned*)(wsb + WS_CTL) + CW_KMAX + bh); }
                    else { const int v = u - 512, b = v >> 4, h = v & 15; knorm_unit(tid, KS + (size_t)b * LKS * D + h * HD, LKS, (unsigned*)(wsb + WS_CTL) + CW_KMAX + 32 + v); } }
                for (int u = vcu; u < 32 + 256; u += G) {
                    if (u < 32) { const int b = u >> 4, h = u & 15; cumsum_unit<32>(lds, tid, LF + (size_t)b * TP * H + h, TP, H, nullptr, 0, TP, Dp + (size_t)u * TP); }
                    else { const int v = u - 32, b = v >> 4, h = v & 15; cumsum_unit<3>(lds, tid, cache_logf + (size_t)b * PAST * H + h, PAST, H, LF + (size_t)(MP + b * TS) * H + h, H, LKS, Ds + (size_t)v * LKS); } }
            }
            SEAM(pb + 1);
        }
        if (SITE(5) && IN(pb + 2) && phase_nonempty(pb + 2)) { SITE_FRAME(); hgrn_scan(gtid, GT, LSEG, gseg, SSTART); SEAM(pb + 2); }
        if (IN(pb + 3)) { SITE_FRAME();
            if (SITE(6) && isA) {
                for (int u = vcu; u < 32 * NSEG + NBS * H; u += G) {
                    if (u < 32 * NSEG) { const int stream = u / NSEG, seg = u % NSEG, b = stream >> 4, h = stream & 15;
                        hgrn_unit<true>(lds, tid, ZQ, ZG, ZV, ZGATE, g_out_a + L * D, OB, b * TP + seg * (SEGC * CH), SEGC, h, seg ? SSTART + ((size_t)(stream * NSEG + seg) << 14) : nullptr,
                                        seg == NSEG - 1 ? out + O_STP + ((size_t)(L * NBP * H + stream) << 14) : nullptr, nullptr); }
                    else { const int v = u - 32 * NSEG, b = v >> 4, h = v & 15;
                        hgrn_unit<true>(lds, tid, ZQ, ZG, ZV, ZGATE, g_out_a + L * D, OB, MP + b * TS, 1, h, state_hgrn + ((size_t)(L * NBS * H + v) << 14), out + O_STS + ((size_t)(L * NBS * H + v) << 14), nullptr); } }
            } else if (SITE(7) && !isA) {
                const float* kmx = (const float*)(wsb + WS_CTL) + CW_KMAX;
                for (int u = vcu; u < 2048 + 256; u += G) {
                    if (u < 2048) { const int bh = u >> 6, qb = u & 63, b = bh >> 4, h = bh & 15; const size_t co = (size_t)h * HD, r0 = (size_t)b * TP + 256 * qb;
                        attn_block(lds, tid, ZQ + r0 * D + co, ZGATE + r0 * D + co, OB + r0 * D + co, KP + (size_t)b * TP * D + co, VP + (size_t)b * TP * D + co, Dp + (size_t)bh * TP, 256 * qb, 256, sqrtf(kmx[bh])); }
                    else { const int v = u - 2048, b = v >> 4, h = v & 15; const size_t co = (size_t)h * HD, r0 = (size_t)MP + b * TS;
                        attn_block(lds, tid, ZQ + r0 * D + co, ZGATE + r0 * D + co, OB + r0 * D + co, KS + (size_t)b * LKS * D + co, VS + (size_t)b * LKS * D + co, Ds + (size_t)v * LKS, PAST, TS, sqrtf(kmx[32 + v])); } }
            }
            SEAM(pb + 3);
        }
        if (SITE(8) && IN(pb + 4)) { SITE_FRAME(); pg8::Gemm g{OB, (isA ? W_AOUT + (size_t)L * D * D : W_BOUT + (size_t)j * D * D), M, D, D}; pg8::StaticOrder S; S.init(M, D, G, bx);
            pg8::EpiRes<false> E{L == 0 ? x_prompt : X, L == 0 ? x_sample : X + (size_t)MP * D, X, X + (size_t)MP * D, XB2, ss + (size_t)(2 * L + 1) * M, nullptr, nullptr};
            pg8::gemm_phase<pg8::EpiRes<false>, pg8::StaticOrder, true, true>(lds, g, S, E, wave0);
            SEAM(pb + 4); }
        if (SITE(9) && IN(pb + 5)) { SITE_FRAME(); pg8::Gemm g{XB2, W_PG + (size_t)L * D * D, M, D, D}; pg8::StaticOrder S; S.init(M, D, G, bx);
            pg8::EpiRes<true> E{X, X + (size_t)MP * D, L == 3 ? out + O_YP : X, L == 3 ? out + O_YS : X + (size_t)MP * D, XB, ss + (size_t)(2 * L + 2) * M, ss + (size_t)(2 * L + 1) * M, EB};
            pg8::gemm_phase<pg8::EpiRes<true>, pg8::StaticOrder, true, true>(lds, g, S, E, wave0);
            SEAM(pb + 5); }
    }
    if (SITE(11) && IN(25)) { SITE_FRAME();
        const float* s8 = ss + (size_t)8 * M;
        for (int m = gw; m < M; m += NGW) { float* yr = out + O_YP + (size_t)m * D; const float rstd = frsq(s8[m] * (1.0f / D) + EPS);
#pragma unroll
            for (int jj = 0; jj < 8; ++jj) { const int c = 256 * jj + 4 * lane; const f32x4 v = *(const f32x4*)(yr + c), gv = *(const f32x4*)(g_final + c); *(f32x4*)(yr + c) = v * rstd * gv; } }
    }
#undef IN
#undef SEAM
}
#undef x_prompt
#undef x_sample
#undef state_hgrn
#undef cache_k
#undef cache_v
#undef cache_logf
#undef p_prompt
#undef p_sample
#undef g_norm_a
#undef w_in_a
#undef lb_logits
#undef g_out_a
#undef w_out_a
#undef g_kv
#undef w_kv
#undef b_f
#undef g_norm_b
#undef w_in_b
#undef w_out_b
#undef w_ple_in
#undef g_ple
#undef w_ple_gate
#undef g_final
#undef ss
#undef lbv
#undef gseg
#undef Dp
#undef Ds
#undef LF
#undef W_AIN
#undef W_AOUT
#undef W_KVQ
#undef W_BIN1
#undef W_BOUT
#undef W_PIN
#undef W_PG
#undef X
#undef XB
#undef XB2
#undef ZQ
#undef ZG
#undef ZV
#undef ZGATE
#undef OB
#undef EB
#undef PB
#undef KS
#undef VS
#undef KP
#undef VP
#undef LSEG
#undef SSTART
#undef out

extern "C" void kernel_launch(void* const* d_in, const int* in_sizes, int n_in, void* d_out, int out_size, void* d_ws, size_t ws_size, hipStream_t stream) {
    static int grid = 0;
    if (grid == 0) {
        if (n_in != 23 || (size_t)out_size != O_END || ws_size < WS_END) { fprintf(stderr, "kernel_launch: unexpected shapes (n_in %d, out %d, ws %zu); nothing launched\n", n_in, out_size, ws_size); grid = -1; return; }
        int dev = 0, cus = 0, per_cu = 0;
        if (hipGetDevice(&dev) != hipSuccess || hipDeviceGetAttribute(&cus, hipDeviceAttributeMultiprocessorCount, dev) != hipSuccess) { grid = -1; return; }
        if (hipFuncSetAttribute((const void*)fwd, hipFuncAttributeMaxDynamicSharedMemorySize, LDS_BYTES) != hipSuccess) { fprintf(stderr, "kernel_launch: hipFuncSetAttribute failed\n"); grid = -1; return; }
        if (hipOccupancyMaxActiveBlocksPerMultiprocessor(&per_cu, (const void*)fwd, NWAVES * 64, LDS_BYTES) != hipSuccess || per_cu < 1) { fprintf(stderr, "kernel_launch: occupancy query says %d\n", per_cu); }
        (void)hipGetLastError();
        grid = cus;
    }
    if (grid < 0) return;
    (void)hipMemsetAsync((char*)d_ws + WS_CTL, 0, CTL_ZERO_BYTES, stream);
    Args a{};
    for (int i = 0; i < 23; ++i) a.in[i] = (const float*)d_in[i];
    a.out = (float*)d_out; a.ws = (unsigned char*)d_ws;
#ifndef MK_PER_PHASE
    a.ph_lo = 0; a.ph_hi = N_PHASES;
    hipLaunchKernelGGL(fwd, dim3(grid), dim3(NWAVES * 64), LDS_BYTES, stream, a);
#else
    for (int p = 0; p < N_PHASES; ++p) { if (!phase_nonempty(p)) continue; a.ph_lo = p; a.ph_hi = p + 1; hipLaunchKernelGGL(fwd, dim3(grid), dim3(NWAVES * 64), LDS_BYTES, stream, a); }
#endif
}
#endif
```

```cpp
#ifndef EMU_HOST
#include <hip/hip_runtime.h>
#endif
#include <cstdio>
#include <cstdint>

constexpr int D = 2048, H = 16, HD = 128, DPLE = 256;
constexpr int NBP = 2, TP = 16384, MP = NBP * TP;
constexpr int NBS = 16, TS = 64, MS = NBS * TS;
constexpr int M = MP + MS;
constexpr int PAST = 1024, LKS = PAST + TS;
constexpr int NSEG = 16, SEGC = 16, CH = 64;
constexpr int NKVQ = 8448;
constexpr float EPS = 1e-6f;
constexpr float LOG2E = 1.4426950408889634f;

constexpr size_t O_YP = 0, O_YS = O_YP + (size_t)MP * D, O_STP = O_YS + (size_t)MS * D, O_STS = O_STP + (size_t)2 * NBP * H * HD * HD,
                 O_KP = O_STS + (size_t)2 * NBS * H * HD * HD, O_VP = O_KP + (size_t)MP * D, O_LFP = O_VP + (size_t)MP * D, O_KS = O_LFP + (size_t)MP * H,
                 O_VS = O_KS + (size_t)MS * D, O_LFS = O_VS + (size_t)MS * D, O_END = O_LFS + (size_t)MS * H;
static_assert(O_END == 217595904ull, "output size");

constexpr size_t MiB = 1u << 20;
constexpr size_t WS_CTL = 0, CTL_ZERO_BYTES = 3 * MiB;
constexpr size_t WS_SS = 1 * MiB;
constexpr size_t WS_LBV = 3 * MiB;
constexpr size_t WS_GSEG = 3 * MiB + 64 * 1024;
constexpr size_t WS_DP = 4 * MiB, WS_DS = 6 * MiB, WS_LF = 8 * MiB;
constexpr size_t WS_WAIN = 12 * MiB, WS_WAOUT = 76 * MiB, WS_WKVQ = 92 * MiB, WS_WBIN1 = 125 * MiB, WS_WBOUT = 141 * MiB, WS_WPIN = 157 * MiB, WS_WPG = 161 * MiB;
constexpr size_t WS_X = 193 * MiB, WS_XB = 457 * MiB, WS_ZQ = 589 * MiB, WS_ZG = 721 * MiB, WS_ZV = 853 * MiB, WS_ZGATE = 985 * MiB, WS_OB = 1117 * MiB, WS_EB = 1249 * MiB;
constexpr size_t WS_PB = 1381 * MiB, WS_KS = 1447 * MiB, WS_VS = 1515 * MiB, WS_LSEG = 1583 * MiB, WS_SSTART = 1615 * MiB, WS_XB2 = 1647 * MiB, WS_END = 1779 * MiB;
constexpr size_t WS_KP = WS_ZG, WS_VP = WS_ZV;
static_assert(WS_SS + 9ull * M * 4 <= CTL_ZERO_BYTES && (size_t)M * D * 2 == 132 * MiB && (size_t)NKVQ * D * 2 <= 33 * MiB && (size_t)NBS * LKS * D * 2 <= 68 * MiB, "ws map");
constexpr int CW_TMO = 0, CW_BAR = 4096, CW_KMAX = 8192;

constexpr int RING_BYTES = 131072, LDSCTL_OFF = RING_BYTES, MISC_OFF = LDSCTL_OFF + 320, LDS_BYTES = 147456, NWAVES = 8;

typedef unsigned short bf16_t;
typedef short bf16x8 __attribute__((ext_vector_type(8)));
typedef float f32x4 __attribute__((ext_vector_type(4)));
typedef float f32x2 __attribute__((ext_vector_type(2)));
typedef unsigned u32x4 __attribute__((ext_vector_type(4)));
typedef unsigned u32x2 __attribute__((ext_vector_type(2)));
typedef _Float16 h16x2 __attribute__((ext_vector_type(2)));

#ifndef EMU_HOST
#define DEV __device__ __forceinline__
#define GAS __attribute__((address_space(1)))
#define LAS __attribute__((address_space(3)))
#define BLOCK_SYNC() __syncthreads()
#define SHFL_XOR(v, m) __shfl_xor((v), (m))
#define MFMA16(a, b, c) __builtin_amdgcn_mfma_f32_16x16x32_bf16((a), (b), (c), 0, 0, 0)
#define ATOMIC_ADD_F32(p, v) ((void)__hip_atomic_fetch_add((p), (v), __ATOMIC_RELAXED, __HIP_MEMORY_SCOPE_AGENT))
#define ATOMIC_MAX_U32(p, v) ((void)__hip_atomic_fetch_max((p), (v), __ATOMIC_RELAXED, __HIP_MEMORY_SCOPE_AGENT))
DEV float fexp(float x) { return __expf(x); }
DEV float fexp2(float x) { return __builtin_amdgcn_exp2f(x); }
DEV float flog(float x) { return __logf(x); }
DEV float frcp(float x) { return __builtin_amdgcn_rcpf(x); }
DEV float frsq(float x) { return __builtin_amdgcn_rsqf(x); }
DEV unsigned pk2(float lo, float hi) { unsigned r; asm volatile("v_cvt_pk_bf16_f32 %0, %1, %2" : "=v"(r) : "v"(lo), "v"(hi)); return r; }
#endif
DEV float bf_lo(unsigned w) { return __builtin_bit_cast(float, w << 16); }
DEV float bf_hi(unsigned w) { return __builtin_bit_cast(float, w & 0xffff0000u); }
DEV float bf2f(bf16_t b) { return __builtin_bit_cast(float, (unsigned)b << 16); }
DEV unsigned pkh2(float lo, float hi) { h16x2 t = {(_Float16)lo, (_Float16)hi}; return __builtin_bit_cast(unsigned, t); }
DEV float h_lo(unsigned w) { h16x2 t = __builtin_bit_cast(h16x2, w); return (float)t.x; }
DEV float h_hi(unsigned w) { h16x2 t = __builtin_bit_cast(h16x2, w); return (float)t.y; }
DEV float sigmoidf_(float z) { return frcp(1.0f + fexp(-z)); }
DEV float siluf_(float z) { return z * frcp(1.0f + fexp(-z)); }

#ifndef EMU_HOST
namespace pg8 {
#define PG8_LAS __attribute__((address_space(3)))
typedef unsigned short bf16_t;
typedef short bf16x8 __attribute__((ext_vector_type(8)));
typedef float f32x4 __attribute__((ext_vector_type(4)));
typedef unsigned u32x4 __attribute__((ext_vector_type(4)));
constexpr int BM = 256, BK = 64, HALF = 128, HTB = HALF * BK * 2  , STAGE_BYTES = 8 * HTB, NXCD = 8, WGM = 8;

__host__ __device__ __forceinline__ int lds_byte(int r, int c) { const int st = (r >> 4) * 2 + (c >> 5), rr = r & 15, cc = c & 31, ob = rr * 64 + cc * 2; return st * 1024 + (ob ^ (((ob >> 9) & 1) << 5)); }
__host__ __device__ __forceinline__ void stage_rc(int b, int& R, int& C) { const int st = b / 1024, sb = b % 1024, swz = sb ^ (((sb >> 9) & 1) << 5); R = (st >> 1) * 16 + swz / 64; C = (st & 1) * 32 + (swz % 64) / 2; }
__host__ __device__ __forceinline__ int perm32(int rho) { const int n = rho >> 4, i = rho & 15; return 8 * (i >> 2) + 4 * n + (i & 3); }

struct Unit { int pm, pn; };
struct Gemm { const bf16_t* A; const bf16_t* Bt; int M, N, K; };

struct StaticOrder {
    int nM, nN, nwg, G, c;
    __host__ __device__ void init(int M, int N, int G_, int c_) { nM = M / BM; nN = N / BM; nwg = nM * nN; G = G_; c = c_; }
    __host__ __device__ bool next(int i, Unit& u) const {
        const long L = (long)i * G + c; if (L >= nwg) return false;
        int wgid = (int)L; { const int q = nwg / NXCD, r = nwg % NXCD, xcd = wgid % NXCD, off = wgid / NXCD; wgid = (xcd < r ? xcd * (q + 1) : r * (q + 1) + (xcd - r) * q) + off; }
        const int nig = WGM * nN, gid = wgid / nig, fm = gid * WGM, gsz = (nM - fm) < WGM ? (nM - fm) : WGM;
        u.pm = fm + ((wgid % nig) % gsz); u.pn = (wgid % nig) / gsz; return true;
    }
    __device__ __forceinline__ void a_ready(const Unit&) const {}
    __device__ __forceinline__ void done(const Unit&) const {}
};

__device__ __forceinline__ unsigned cvt_pk_bf16(float lo, float hi) { unsigned r; asm volatile("v_cvt_pk_bf16_f32 %0, %1, %2" : "=v"(r) : "v"(lo), "v"(hi)); return r; }
typedef float f32x2 __attribute__((ext_vector_type(2)));

__device__ __forceinline__ void zero_acc(f32x4 (&acc)[2][2][4][2]) {
#pragma unroll
    for (int a = 0; a < 2; ++a)
#pragma unroll
        for (int b = 0; b < 2; ++b)
#pragma unroll
            for (int m = 0; m < 4; ++m)
#pragma unroll
                for (int n = 0; n < 2; ++n) acc[a][b][m][n] = (f32x4){0.f, 0.f, 0.f, 0.f};
}
struct EpiBf16 {
    static constexpr bool PERM = true, AFTER_DRAIN = false;
    bf16_t* O; int ldc;
    __device__ __forceinline__ void init(f32x4 (&acc)[2][2][4][2], const Unit&, int, int, int, int) const { zero_acc(acc); }
    __device__ __forceinline__ void operator()(const f32x4 (&acc)[2][2][4][2], const Unit& u, int wr, int wc, int fr, int fq) const {
        const int row0 = u.pm * BM + wr * 64 + fr, col0 = u.pn * BM + wc * 32 + 8 * fq;
#pragma unroll
        for (int ai = 0; ai < 2; ++ai)
#pragma unroll
            for (int m = 0; m < 4; ++m) { bf16_t* rowp = O + (size_t)(row0 + ai * HALF + m * 16) * ldc + col0;
#pragma unroll
                for (int bj = 0; bj < 2; ++bj) { const f32x4 v0 = acc[ai][bj][m][0], v1 = acc[ai][bj][m][1];
                    u32x4 w; w.x = cvt_pk_bf16(v0[0], v0[1]); w.y = cvt_pk_bf16(v0[2], v0[3]); w.z = cvt_pk_bf16(v1[0], v1[1]); w.w = cvt_pk_bf16(v1[2], v1[3]);
                    *(u32x4*)(rowp + bj * HALF) = w; } }
    }
};

struct EpiAin {
    static constexpr bool PERM = true, AFTER_DRAIN = false;
    const float* ss; const float* lb; bf16_t* zq; bf16_t* zg; bf16_t* zv; bf16_t* zgate;
    __device__ __forceinline__ void init(f32x4 (&acc)[2][2][4][2], const Unit&, int, int, int, int) const { zero_acc(acc); }
    template <int TYPE> __device__ __forceinline__ void run(const f32x4 (&acc)[2][2][4][2], const Unit& u, int wr, int wc, int fr, int fq, bf16_t* base) const {
        const int ct = (u.pn & 7) * BM + wc * 32 + 8 * fq, row0 = u.pm * BM + wr * 64 + fr;
        float rs[8];
#pragma unroll
        for (int i = 0; i < 8; ++i) rs[i] = ss[row0 + (i >> 2) * HALF + (i & 3) * 16];
#pragma unroll
        for (int ai = 0; ai < 2; ++ai)
#pragma unroll
            for (int m = 0; m < 4; ++m) { const int row = row0 + ai * HALF + m * 16; const float rstd = frsq(rs[ai * 4 + m] * (1.0f / D) + EPS);
                bf16_t* rowp = base + (size_t)row * D + ct;
#pragma unroll
                for (int bj = 0; bj < 2; ++bj) { f32x4 v0 = acc[ai][bj][m][0] * rstd, v1 = acc[ai][bj][m][1] * rstd; u32x4 w;
                    if (TYPE == 1) {
                        const f32x4 l0 = *(const f32x4*)(lb + ct + bj * HALF), l1 = *(const f32x4*)(lb + ct + bj * HALF + 4);
#pragma unroll
                        for (int j = 0; j < 4; ++j) { v0[j] = fmaxf(flog(l0[j] + (1.0f - l0[j]) * sigmoidf_(v0[j])), -80.0f); v1[j] = fmaxf(flog(l1[j] + (1.0f - l1[j]) * sigmoidf_(v1[j])), -80.0f); }
                        w.x = pkh2(v0[0], v0[1]); w.y = pkh2(v0[2], v0[3]); w.z = pkh2(v1[0], v1[1]); w.w = pkh2(v1[2], v1[3]);
                    } else {
                        if (TYPE == 0) {
#pragma unroll
                            for (int j = 0; j < 4; ++j) { v0[j] = siluf_(v0[j]); v1[j] = siluf_(v1[j]); } }
                        w.x = cvt_pk_bf16(v0[0], v0[1]); w.y = cvt_pk_bf16(v0[2], v0[3]); w.z = cvt_pk_bf16(v1[0], v1[1]); w.w = cvt_pk_bf16(v1[2], v1[3]);
                    }
                    *(u32x4*)(rowp + bj * HALF) = w; } }
    }
    __device__ __forceinline__ void operator()(const f32x4 (&acc)[2][2][4][2], const Unit& u, int wr, int wc, int fr, int fq) const {
        const int type = u.pn >> 3;
        if (type == 0) run<0>(acc, u, wr, wc, fr, fq, zq); else if (type == 1) run<1>(acc, u, wr, wc, fr, fq, zg); else if (type == 2) run<2>(acc, u, wr, wc, fr, fq, zv); else run<0>(acc, u, wr, wc, fr, fq, zgate);
    }
};

struct EpiBin {
    static constexpr bool PERM = true, AFTER_DRAIN = false;
    const float* ss; int tbase; bf16_t* kp; bf16_t* vp; bf16_t* ks; bf16_t* vs; bf16_t* zq; bf16_t* zgate; float* out; float* lf; const float* bf;
    __device__ __forceinline__ void init(f32x4 (&acc)[2][2][4][2], const Unit&, int, int, int, int) const { zero_acc(acc); }
    template <int TYPE> __device__ __forceinline__ void run(const f32x4 (&acc)[2][2][4][2], const Unit& u, int wr, int wc, int fr, int fq) const {
        const int ct = (u.pn & 7) * BM + wc * 32 + 8 * fq, row0 = u.pm * BM + wr * 64 + fr; const bool smp = u.pm >= MP / BM;
        float rs[8];
#pragma unroll
        for (int i = 0; i < 8; ++i) rs[i] = ss[row0 + (i >> 2) * HALF + (i & 3) * 16];
#pragma unroll
        for (int ai = 0; ai < 2; ++ai)
#pragma unroll
            for (int m = 0; m < 4; ++m) { const int row = row0 + ai * HALF + m * 16; const float rstd = frsq(rs[ai * 4 + m] * (1.0f / D) + EPS);
                const int ms = row - MP;
                if (TYPE == 4) {
                    if (wc == 0 && fq < 2) { const f32x4 v0 = acc[ai][0][m][0] * rstd + *(const f32x4*)(bf + 8 * fq), v1 = acc[ai][0][m][1] * rstd + *(const f32x4*)(bf + 8 * fq + 4); f32x4 r0, r1;
#pragma unroll
                        for (int j = 0; j < 4; ++j) { r0[j] = fminf(v0[j], 0.f) - log1pf(expf(-fabsf(v0[j]))); r1[j] = fminf(v1[j], 0.f) - log1pf(expf(-fabsf(v1[j]))); }
                        float* o = smp ? out + O_LFS + (size_t)ms * H + 8 * fq : out + O_LFP + (size_t)row * H + 8 * fq; float* l = lf + (size_t)row * H + 8 * fq;
                        *(f32x4*)o = r0; *(f32x4*)(o + 4) = r1; *(f32x4*)l = r0; *(f32x4*)(l + 4) = r1; }
                } else {
                    bf16_t* rowp; float* orow = nullptr;
                    if (TYPE == 0 || TYPE == 1) {
                        if (smp) { const size_t kr = (size_t)(ms / TS) * LKS + PAST + (ms % TS); rowp = (TYPE == 0 ? ks : vs) + kr * D + ct; orow = out + (TYPE == 0 ? O_KS : O_VS) + (size_t)ms * D + ct; }
                        else { rowp = (TYPE == 0 ? kp : vp) + (size_t)row * D + ct; orow = out + (TYPE == 0 ? O_KP : O_VP) + (size_t)row * D + ct; }
                    } else rowp = (TYPE == 2 ? zq : zgate) + (size_t)row * D + ct;
#pragma unroll
                    for (int bj = 0; bj < 2; ++bj) { f32x4 v0 = acc[ai][bj][m][0] * rstd, v1 = acc[ai][bj][m][1] * rstd;
                        if (TYPE == 0 || TYPE == 1) { *(f32x4*)(orow + bj * HALF) = v0; *(f32x4*)(orow + bj * HALF + 4) = v1; }
                        if (TYPE == 3) {
#pragma unroll
                            for (int j = 0; j < 4; ++j) { v0[j] = siluf_(v0[j]); v1[j] = siluf_(v1[j]); } }
                        u32x4 w; w.x = cvt_pk_bf16(v0[0], v0[1]); w.y = cvt_pk_bf16(v0[2], v0[3]); w.z = cvt_pk_bf16(v1[0], v1[1]); w.w = cvt_pk_bf16(v1[2], v1[3]);
                        *(u32x4*)(rowp + bj * HALF) = w; }
                } }
    }
    __device__ __forceinline__ void operator()(const f32x4 (&acc)[2][2][4][2], const Unit& u, int wr, int wc, int fr, int fq) const {
        const int type = (u.pn >> 3) + tbase;
        if (type == 0) run<0>(acc, u, wr, wc, fr, fq); else if (type == 1) run<1>(acc, u, wr, wc, fr, fq); else if (type == 2) run<2>(acc, u, wr, wc, fr, fq); else if (type == 3) run<3>(acc, u, wr, wc, fr, fq); else run<4>(acc, u, wr, wc, fr, fq);
    }
};

template <bool PLE> struct EpiRes {
    static constexpr bool PERM = false, AFTER_DRAIN = false;
    const float* xin_p; const float* xin_s; float* xout_p; float* xout_s; bf16_t* xb; float* ss_out; const float* ss_in; const bf16_t* e;
    __device__ __forceinline__ void init(f32x4 (&acc)[2][2][4][2], const Unit& u, int wr, int wc, int fr, int fq) const {
        if (PLE) { zero_acc(acc); return; }
        const int row0 = u.pm * BM + wr * 64 + fr, col0 = u.pn * BM + wc * 32 + 4 * fq; const bool smp = u.pm >= MP / BM;
        const float* xi = (smp ? xin_s : xin_p) + (size_t)(row0 - (smp ? MP : 0)) * D + col0;
#pragma unroll
        for (int ai = 0; ai < 2; ++ai)
#pragma unroll
            for (int m = 0; m < 4; ++m)
#pragma unroll
                for (int bj = 0; bj < 2; ++bj)
#pragma unroll
                    for (int n = 0; n < 2; ++n) acc[ai][bj][m][n] = *(const f32x4*)(xi + (size_t)(ai * HALF + m * 16) * D + bj * HALF + n * 16);
    }
    __device__ __forceinline__ void operator()(const f32x4 (&acc)[2][2][4][2], const Unit& u, int wr, int wc, int fr, int fq) const {
        const int row0 = u.pm * BM + wr * 64 + fr, col0 = u.pn * BM + wc * 32 + 4 * fq; const bool smp = u.pm >= MP / BM;
        const float* xi = (smp ? xin_s : xin_p) + (size_t)(row0 - (smp ? MP : 0)) * D + col0; float* xo = (smp ? xout_s : xout_p) + (size_t)(row0 - (smp ? MP : 0)) * D + col0;
        bf16_t* xbp = xb + (size_t)row0 * D + col0; const bf16_t* ep = e + (size_t)row0 * D + col0;
        float sacc[8], rs[8];
        if (PLE) {
#pragma unroll
            for (int i = 0; i < 8; ++i) rs[i] = ss_in[row0 + (i >> 2) * HALF + (i & 3) * 16]; }
#pragma unroll
        for (int ai = 0; ai < 2; ++ai)
#pragma unroll
            for (int mp = 0; mp < 2; ++mp) {
                f32x4 xv[2][2][2]; u32x2 ev[2][2][2];
                if (PLE) {
#pragma unroll
                    for (int mm = 0; mm < 2; ++mm)
#pragma unroll
                        for (int bj = 0; bj < 2; ++bj)
#pragma unroll
                            for (int n = 0; n < 2; ++n) { const size_t o = (size_t)(ai * HALF + (2 * mp + mm) * 16) * D + bj * HALF + n * 16; xv[mm][bj][n] = *(const f32x4*)(xi + o); ev[mm][bj][n] = *(const u32x2*)(ep + o); } }
#pragma unroll
                for (int mm = 0; mm < 2; ++mm) { const int m = 2 * mp + mm; float rstd = 1.f; if (PLE) rstd = frsq(rs[ai * 4 + m] * (1.0f / D) + EPS); float s = 0.f;
#pragma unroll
                    for (int bj = 0; bj < 2; ++bj)
#pragma unroll
                        for (int n = 0; n < 2; ++n) { const size_t o = (size_t)(ai * HALF + m * 16) * D + bj * HALF + n * 16; f32x4 xn = acc[ai][bj][m][n];
                            if (PLE) { const f32x4 a = xn * rstd; const u32x2 w = ev[mm][bj][n];
                                xn[0] = xv[mm][bj][n][0] + sigmoidf_(a[0]) * bf_lo(w.x); xn[1] = xv[mm][bj][n][1] + sigmoidf_(a[1]) * bf_hi(w.x); xn[2] = xv[mm][bj][n][2] + sigmoidf_(a[2]) * bf_lo(w.y); xn[3] = xv[mm][bj][n][3] + sigmoidf_(a[3]) * bf_hi(w.y); }
                            *(f32x4*)(xo + o) = xn;
                            u32x2 wb; wb.x = cvt_pk_bf16(xn[0], xn[1]); wb.y = cvt_pk_bf16(xn[2], xn[3]); *(u32x2*)(xbp + o) = wb;
                            s += (xn[0] * xn[0] + xn[1] * xn[1]) + (xn[2] * xn[2] + xn[3] * xn[3]); }
                    s += __shfl_xor(s, 16); s += __shfl_xor(s, 32); sacc[ai * 4 + m] = s; } }
#pragma unroll
        for (int j = 0; j < 2; ++j) { const float v = fq == 0 ? sacc[4 * j] : fq == 1 ? sacc[4 * j + 1] : fq == 2 ? sacc[4 * j + 2] : sacc[4 * j + 3];
            __hip_atomic_fetch_add(ss_out + row0 + j * HALF + fq * 16, v, __ATOMIC_RELAXED, __HIP_MEMORY_SCOPE_AGENT); }
    }
};

template <class Epi, class Sched, bool ALIGN_EPI = false, bool SP2 = false>
__device__ __forceinline__ void gemm_phase(PG8_LAS unsigned char* lds, const Gemm g, const Sched& S, const Epi& E, const int wave_in) {
    int tid_; asm volatile("v_mbcnt_lo_u32_b32 %0, -1, 0\n\tv_mbcnt_hi_u32_b32 %0, -1, %0" : "=v"(tid_)); tid_ += wave_in * 64;
    const int tid = tid_, wid = __builtin_amdgcn_readfirstlane(tid >> 6), lane = tid & 63, wr = wid >> 2, wc = wid & 3, fr = lane & 15, fq = lane >> 4;
    const int K = g.K, nt = K / BK;
    unsigned voffA[2], voffB[2];
#pragma unroll
    for (int i = 0; i < 2; ++i) { int R, C; stage_rc(tid * 16 + i * 8192, R, C); const int Rb = Epi::PERM ? ((R & ~31) + perm32(R & 31)) : R;
        voffA[i] = (unsigned)(R * K + C) * 2u; voffB[i] = (unsigned)(Rb * K + C) * 2u; }
    const size_t kstep = (size_t)(BK * 2);
    const size_t hstep = (size_t)HALF * K * 2;
    const size_t tstep = 2 * hstep;
    const unsigned ldsw = (unsigned)wid * 1024u;
    const int aoff = lds_byte(wr * 64 + fr, fq * 8), boff = lds_byte(wc * 32 + fr, fq * 8);
#define PG8_SA(b, h) (((b) * 2 + (h)) * HTB)
#define PG8_SB(b, h) ((4 + (b) * 2 + (h)) * HTB)
#define PG8_STAGE(bufoff, gbase, voff) do { _Pragma("unroll") for (int _i = 0; _i < 2; ++_i) \
        __builtin_amdgcn_global_load_lds((const unsigned*)((const char*)(gbase) + (voff)[_i]), (PG8_LAS unsigned*)(lds + (bufoff) + ldsw + _i * 8192), 16, 0, 0); } while (0)
#define PG8_LDA(dst, b, h) do { _Pragma("unroll") for (int m = 0; m < 4; ++m) _Pragma("unroll") for (int k = 0; k < 2; ++k) dst[m][k] = *(const PG8_LAS bf16x8*)(lds + PG8_SA(b, h) + aoff + m * 2048 + k * 1024); } while (0)
#define PG8_LDB(dst, b, h) do { _Pragma("unroll") for (int n = 0; n < 2; ++n) _Pragma("unroll") for (int k = 0; k < 2; ++k) dst[n][k] = *(const PG8_LAS bf16x8*)(lds + PG8_SB(b, h) + boff + n * 2048 + k * 1024); } while (0)
#define PG8_MMA(ai, bj, At, Bt) do { __builtin_amdgcn_s_setprio(1); _Pragma("unroll") for (int m = 0; m < 4; ++m) _Pragma("unroll") for (int n = 0; n < 2; ++n) _Pragma("unroll") for (int k = 0; k < 2; ++k) \
        acc[ai][bj][m][n] = __builtin_amdgcn_mfma_f32_16x16x32_bf16(Bt[n][k], At[m][k], acc[ai][bj][m][n], 0, 0, 0); __builtin_amdgcn_s_setprio(0); } while (0)
#define PG8_WAIT_V(n) asm volatile("s_waitcnt vmcnt(" #n ")" ::: "memory")
#define PG8_WAIT_L(n) asm volatile("s_waitcnt lgkmcnt(" #n ")" ::: "memory")
#define PG8_BAR __builtin_amdgcn_s_barrier()
#define PG8_SCHED __builtin_amdgcn_sched_barrier(0)
    Unit cur, nxt; int ui = 0;
    if (!S.next(0, cur)) return;
    f32x4 acc[2][2][4][2];
    E.init(acc, cur, wr, wc, fr, fq);
    bf16x8 At[4][2], B0[2][2], B1[2][2];
    const char* cA = (const char*)g.A + (size_t)cur.pm * tstep; const char* cB = (const char*)g.Bt + (size_t)cur.pn * tstep;
    S.a_ready(cur);
    if constexpr (SP2) {
        PG8_STAGE(PG8_SB(0, 0), cB, voffB); PG8_STAGE(PG8_SB(0, 1), cB + hstep, voffB); PG8_STAGE(PG8_SA(0, 0), cA, voffA); PG8_STAGE(PG8_SA(0, 1), cA + hstep, voffA);
        if (wr == 1) PG8_BAR;
        PG8_WAIT_V(2); PG8_BAR;
        PG8_STAGE(PG8_SB(1, 0), cB + kstep, voffB); PG8_STAGE(PG8_SA(1, 0), cA + kstep, voffA); PG8_STAGE(PG8_SB(1, 1), cB + hstep + kstep, voffB);
        PG8_WAIT_V(6); PG8_BAR;
    } else {
        PG8_STAGE(PG8_SB(0, 0), cB, voffB); PG8_STAGE(PG8_SA(0, 0), cA, voffA); PG8_STAGE(PG8_SB(0, 1), cB + hstep, voffB); PG8_STAGE(PG8_SA(0, 1), cA + hstep, voffA);
        if (wr == 1) PG8_BAR;
        PG8_WAIT_V(4); PG8_BAR;
        PG8_STAGE(PG8_SB(1, 0), cB + kstep, voffB); PG8_STAGE(PG8_SA(1, 0), cA + kstep, voffA); PG8_STAGE(PG8_SB(1, 1), cB + hstep + kstep, voffB);
        PG8_WAIT_V(6); PG8_BAR;
    }
    for (;;) {
        const bool has_next = S.next(ui + 1, nxt);
        const char* nA = has_next ? (const char*)g.A + (size_t)nxt.pm * tstep : cA; const char* nB = has_next ? (const char*)g.Bt + (size_t)nxt.pn * tstep : cB;
        for (int t = 0; t < nt; t += 2) {
            const bool last = (t == nt - 2);
            const char* a1 = cA + (size_t)(t + 1) * kstep;
            const char* a2 = last ? nA : cA + (size_t)(t + 2) * kstep; const char* b2 = last ? nB : cB + (size_t)(t + 2) * kstep;
            const char* a3 = a2 + kstep; const char* b3 = b2 + kstep;
            if (last && has_next) S.a_ready(nxt);
            if constexpr (SP2) {
            PG8_LDB(B0, 0, 0); PG8_LDB(B1, 0, 1); PG8_SCHED; PG8_LDA(At, 0, 0); PG8_STAGE(PG8_SA(1, 1), a1 + hstep, voffA);
            PG8_WAIT_V(8); PG8_WAIT_L(0); PG8_BAR; PG8_MMA(0, 0, At, B0); PG8_MMA(0, 1, At, B1); PG8_BAR; PG8_SCHED;
            PG8_LDA(At, 0, 1); PG8_STAGE(PG8_SB(0, 0), b2, voffB); PG8_STAGE(PG8_SB(0, 1), b2 + hstep, voffB); PG8_STAGE(PG8_SA(0, 0), a2, voffA);
            PG8_WAIT_V(8); PG8_WAIT_L(0); PG8_BAR; PG8_MMA(1, 0, At, B0); PG8_MMA(1, 1, At, B1); PG8_BAR; PG8_SCHED;
            PG8_LDB(B0, 1, 0); PG8_LDB(B1, 1, 1); PG8_SCHED; PG8_LDA(At, 1, 0); PG8_STAGE(PG8_SA(0, 1), a2 + hstep, voffA);
            PG8_WAIT_V(8); PG8_WAIT_L(0); PG8_BAR; PG8_MMA(0, 0, At, B0); PG8_MMA(0, 1, At, B1); PG8_BAR; PG8_SCHED;
            PG8_LDA(At, 1, 1); PG8_STAGE(PG8_SB(1, 0), b3, voffB); PG8_STAGE(PG8_SB(1, 1), b3 + hstep, voffB); PG8_STAGE(PG8_SA(1, 0), a3, voffA);
            PG8_WAIT_V(8); PG8_WAIT_L(0); PG8_BAR; PG8_MMA(1, 0, At, B0); PG8_MMA(1, 1, At, B1); PG8_BAR; PG8_SCHED;
            } else {
            PG8_LDB(B0, 0, 0); PG8_SCHED; PG8_LDA(At, 0, 0); PG8_STAGE(PG8_SA(1, 1), a1 + hstep, voffA);
            PG8_WAIT_L(8); PG8_BAR; PG8_WAIT_L(0); PG8_MMA(0, 0, At, B0); PG8_BAR; PG8_SCHED;
            PG8_LDB(B1, 0, 1); PG8_STAGE(PG8_SB(0, 0), b2, voffB);
            PG8_BAR; PG8_WAIT_L(0); PG8_MMA(0, 1, At, B1); PG8_BAR;
            PG8_LDA(At, 0, 1); PG8_STAGE(PG8_SA(0, 0), a2, voffA);
            PG8_BAR; PG8_WAIT_L(0); PG8_MMA(1, 0, At, B0); PG8_BAR; PG8_SCHED;
            PG8_STAGE(PG8_SB(0, 1), b2 + hstep, voffB);
            PG8_WAIT_V(6); PG8_BAR; PG8_MMA(1, 1, At, B1); PG8_BAR;
            PG8_LDB(B0, 1, 0); PG8_SCHED; PG8_LDA(At, 1, 0); PG8_STAGE(PG8_SA(0, 1), a2 + hstep, voffA);
            PG8_WAIT_L(8); PG8_BAR; PG8_WAIT_L(0); PG8_MMA(0, 0, At, B0); PG8_BAR; PG8_SCHED;
            PG8_LDB(B1, 1, 1); PG8_STAGE(PG8_SB(1, 0), b3, voffB);
            PG8_BAR; PG8_WAIT_L(0); PG8_MMA(0, 1, At, B1); PG8_BAR;
            PG8_LDA(At, 1, 1); PG8_STAGE(PG8_SA(1, 0), a3, voffA);
            PG8_BAR; PG8_WAIT_L(0); PG8_MMA(1, 0, At, B0); PG8_BAR; PG8_SCHED;
            PG8_STAGE(PG8_SB(1, 1), b3 + hstep, voffB);
            PG8_WAIT_V(6); PG8_BAR; PG8_MMA(1, 1, At, B1); PG8_BAR;
            }
        }
        if constexpr (ALIGN_EPI) { if (wr == 0) PG8_BAR; }
        if constexpr (!Epi::AFTER_DRAIN) { E(acc, cur, wr, wc, fr, fq); S.done(cur); }
        if (!has_next) break;
        E.init(acc, nxt, wr, wc, fr, fq);
        cur = nxt; cA = nA; cB = nB; ++ui;
        if constexpr (ALIGN_EPI) { if (wr == 1) PG8_BAR; }
    }
    PG8_WAIT_V(0);
    if constexpr (!ALIGN_EPI) { if (wr == 0) PG8_BAR; }
    PG8_BAR;
    if constexpr (Epi::AFTER_DRAIN) { E.fused(acc, cur, wr, wc, fr, fq, lds, wid, lane); S.done(cur); }
#undef PG8_SA
#undef PG8_SB
#undef PG8_STAGE
#undef PG8_LDA
#undef PG8_LDB
#undef PG8_MMA
#undef PG8_WAIT_V
#undef PG8_WAIT_L
#undef PG8_BAR
#undef PG8_SCHED
}
}
#endif
#ifndef EMU_HOST
#define SCHED_FENCE() __builtin_amdgcn_sched_barrier(0)
#define OPAQUE(v) asm volatile("" : "+v"(v))
#define UNIFORM(x) __builtin_amdgcn_readfirstlane(x)
#define WAVE_ALL(p) (__all(p) != 0)
#else
#define SCHED_FENCE() do {} while (0)
#define OPAQUE(v) do {} while (0)
#define UNIFORM(x) (x)
#define WAVE_ALL(p) (p)
#endif
constexpr int HG_QM = 0, HG_KM = 17408, HG_KMT = 34816, HG_VT = 53248, HG_A = 71680, HG_VEC = 80896, HG_GSUM = 82432, HG_OSQ = 86528, HG_END = 88576;
static_assert(HG_END <= RING_BYTES, "HGRN LDS");

template <bool FULL>
DEV void hgrn_unit(LAS unsigned char* lds, int tid, const bf16_t* zq, const bf16_t* zg, const bf16_t* zv, const bf16_t* zgate, const float* gout, bf16_t* ob,
                   int rowbase, int nchunks, int h, const float* s_init, float* s_out, float* gseg_out) {
    OPAQUE(tid);
    const int lane = tid & 63, w = UNIFORM(tid >> 6), l16 = lane & 15, q4 = lane >> 4, kp = tid & 63, tg = w;
    f32x4 S[8];
    { int so = (4 * q4) * HD + 16 * w + l16;
#pragma unroll
      for (int kb = 0; kb < 8; ++kb) {
#pragma unroll
        for (int r = 0; r < 4; ++r) S[kb][r] = s_init ? s_init[so + r * HD] : 0.f;
        so += 16 * HD; OPAQUE(so); } }
    unsigned pq[8], pg[8], pv[8];
    const size_t colq = (size_t)h * HD + 2 * kp, colo = (size_t)h * HD + 16 * (tid & 7);
#pragma unroll
    for (int i = 0; i < 8; ++i) { const size_t o = (size_t)(rowbase + 8 * tg + i) * D + colq; pg[i] = *(const unsigned*)(zg + o); pv[i] = *(const unsigned*)(zv + o); if (FULL) pq[i] = *(const unsigned*)(zq + o); }
    float gs0 = 0.f, gs1 = 0.f;
    for (int c = 0; c < nchunks; ++c) {
        float G0[8], G1[8], g0[8], g1[8];
        { float c0 = 0.f, c1 = 0.f;
#pragma unroll
          for (int i = 0; i < 8; ++i) { g0[i] = h_lo(pg[i]); g1[i] = h_hi(pg[i]); c0 += g0[i]; c1 += g1[i]; G0[i] = c0; G1[i] = c1; }
          *(LAS f32x2*)(lds + HG_GSUM + (tg * 128 + 2 * kp) * 4) = (f32x2){c0, c1}; }
        BLOCK_SYNC();
        float P0 = 0.f, P1 = 0.f, T0 = 0.f, T1 = 0.f, M0 = 0.f, M1 = 0.f;
#pragma unroll
        for (int j = 0; j < 8; ++j) { const f32x2 s = *(const LAS f32x2*)(lds + HG_GSUM + (j * 128 + 2 * kp) * 4); if (j < tg) { P0 += s.x; P1 += s.y; } if (j < 4) { M0 += s.x; M1 += s.y; } T0 += s.x; T1 += s.y; }
        unsigned kmw[8];
#pragma unroll
        for (int i = 0; i < 8; ++i) { const int t = 8 * tg + i; const float Gt0 = P0 + G0[i], Gt1 = P1 + G1[i];
            const float ek0 = fexp(fminf(M0 - Gt0, 80.f)), ek1 = fexp(fminf(M1 - Gt1, 80.f));
            kmw[i] = pk2((1.f - fexp(g0[i])) * ek0, (1.f - fexp(g1[i])) * ek1);
            if (FULL) { const float eq0 = fexp(fminf(Gt0 - M0, 80.f)), eq1 = fexp(fminf(Gt1 - M1, 80.f));
                *(LAS unsigned*)(lds + HG_QM + t * 272 + 4 * kp) = pk2(bf_lo(pq[i]) * eq0, bf_hi(pq[i]) * eq1);
                *(LAS unsigned*)(lds + HG_KM + t * 272 + 4 * kp) = kmw[i]; } }
        { u32x4 a, b;
          a.x = (kmw[0] & 0xffffu) | (kmw[1] << 16); a.y = (kmw[2] & 0xffffu) | (kmw[3] << 16); a.z = (kmw[4] & 0xffffu) | (kmw[5] << 16); a.w = (kmw[6] & 0xffffu) | (kmw[7] << 16);
          b.x = (kmw[0] >> 16) | (kmw[1] & 0xffff0000u); b.y = (kmw[2] >> 16) | (kmw[3] & 0xffff0000u); b.z = (kmw[4] >> 16) | (kmw[5] & 0xffff0000u); b.w = (kmw[6] >> 16) | (kmw[7] & 0xffff0000u);
          *(LAS u32x4*)(lds + HG_KMT + (2 * kp) * 144 + tg * 16) = a; *(LAS u32x4*)(lds + HG_KMT + (2 * kp + 1) * 144 + tg * 16) = b;
          a.x = (pv[0] & 0xffffu) | (pv[1] << 16); a.y = (pv[2] & 0xffffu) | (pv[3] << 16); a.z = (pv[4] & 0xffffu) | (pv[5] << 16); a.w = (pv[6] & 0xffffu) | (pv[7] << 16);
          b.x = (pv[0] >> 16) | (pv[1] & 0xffff0000u); b.y = (pv[2] >> 16) | (pv[3] & 0xffff0000u); b.z = (pv[4] >> 16) | (pv[5] & 0xffff0000u); b.w = (pv[6] >> 16) | (pv[7] & 0xffff0000u);
          *(LAS u32x4*)(lds + HG_VT + (2 * kp) * 144 + tg * 16) = a; *(LAS u32x4*)(lds + HG_VT + (2 * kp + 1) * 144 + tg * 16) = b; }
        if (tg == 0) { LAS float* vec = (LAS float*)(lds + HG_VEC);
            *(LAS f32x2*)(vec + 2 * kp) = (f32x2){fexp(M0), fexp(M1)}; *(LAS f32x2*)(vec + 128 + 2 * kp) = (f32x2){fexp(T0), fexp(T1)}; *(LAS f32x2*)(vec + 256 + 2 * kp) = (f32x2){fexp(T0 - M0), fexp(T1 - M1)};
            gs0 += T0; gs1 += T1; }
        if (c + 1 < nchunks) {
#pragma unroll
            for (int i = 0; i < 8; ++i) { const size_t o = (size_t)(rowbase + (c + 1) * CH + 8 * tg + i) * D + colq; pg[i] = *(const unsigned*)(zg + o); pv[i] = *(const unsigned*)(zv + o); if (FULL) pq[i] = *(const unsigned*)(zq + o); }
        }
        BLOCK_SYNC();
        u32x4 cgt[2];
        if (FULL) { const bf16_t* gp = zgate + (size_t)(rowbase + c * CH + (tid >> 3)) * D + colo; cgt[0] = *(const u32x4*)gp; cgt[1] = *(const u32x4*)(gp + 8); }
        if (FULL) { const int tb = w & 3;
#pragma unroll
            for (int sbi = 0; sbi < 2; ++sbi) { const int sb = 2 * (w >> 2) + sbi;
                if (sb <= tb) { f32x4 acc = {0.f, 0.f, 0.f, 0.f};
#pragma unroll
                    for (int st = 0; st < 4; ++st) { const bf16x8 a = *(const LAS bf16x8*)(lds + HG_KM + (16 * sb + l16) * 272 + (32 * st + 8 * q4) * 2), b = *(const LAS bf16x8*)(lds + HG_QM + (16 * tb + l16) * 272 + (32 * st + 8 * q4) * 2);
                        acc = MFMA16(a, b, acc); }
                    if (sb == tb) {
#pragma unroll
                        for (int r = 0; r < 4; ++r) if (4 * q4 + r > l16) acc[r] = 0.f; }
                    *(LAS u32x2*)(lds + HG_A + (16 * tb + l16) * 144 + (16 * sb + 4 * q4) * 2) = (u32x2){pk2(acc[0], acc[1]), pk2(acc[2], acc[3])};
                } else if ((sb >> 1) <= (tb >> 1)) *(LAS u32x2*)(lds + HG_A + (16 * tb + l16) * 144 + (16 * sb + 4 * q4) * 2) = (u32x2){0u, 0u};
            }
            BLOCK_SYNC(); }
        const LAS float* vec = (const LAS float*)(lds + HG_VEC);
        bf16x8 vtf[2];
#pragma unroll
        for (int ss = 0; ss < 2; ++ss) vtf[ss] = *(const LAS bf16x8*)(lds + HG_VT + (16 * w + l16) * 144 + (32 * ss + 8 * q4) * 2);
        f32x4 o[4];
        if (FULL) {
            bf16x8 bfr[4];
#pragma unroll
            for (int j = 0; j < 4; ++j) { const f32x4 e0 = *(const LAS f32x4*)(vec + 32 * j + 4 * q4), e1 = *(const LAS f32x4*)(vec + 32 * j + 16 + 4 * q4);
                u32x4 t; t.x = pk2(S[2 * j][0] * e0[0], S[2 * j][1] * e0[1]); t.y = pk2(S[2 * j][2] * e0[2], S[2 * j][3] * e0[3]); t.z = pk2(S[2 * j + 1][0] * e1[0], S[2 * j + 1][1] * e1[1]); t.w = pk2(S[2 * j + 1][2] * e1[2], S[2 * j + 1][3] * e1[3]);
                bfr[j] = __builtin_bit_cast(bf16x8, t); }
#pragma unroll
            for (int tb = 0; tb < 4; ++tb) { f32x4 acc = {0.f, 0.f, 0.f, 0.f};
#pragma unroll
                for (int j = 0; j < 4; ++j) { const u32x2 a0 = *(const LAS u32x2*)(lds + HG_QM + (16 * tb + l16) * 272 + (32 * j + 4 * q4) * 2), a1 = *(const LAS u32x2*)(lds + HG_QM + (16 * tb + l16) * 272 + (32 * j + 16 + 4 * q4) * 2);
                    const u32x4 t = {a0.x, a0.y, a1.x, a1.y}; acc = MFMA16(__builtin_bit_cast(bf16x8, t), bfr[j], acc); }
#pragma unroll
                for (int ss = 0; ss < 2; ++ss) if (ss == 0 || tb >= 2) { const bf16x8 a = *(const LAS bf16x8*)(lds + HG_A + (16 * tb + l16) * 144 + (32 * ss + 8 * q4) * 2); acc = MFMA16(a, vtf[ss], acc); }
                o[tb] = acc; SCHED_FENCE(); }
        }
#pragma unroll
        for (int kb = 0; kb < 8; ++kb) { f32x4 u = {0.f, 0.f, 0.f, 0.f};
#pragma unroll
            for (int ss = 0; ss < 2; ++ss) { const bf16x8 a = *(const LAS bf16x8*)(lds + HG_KMT + (16 * kb + l16) * 144 + (32 * ss + 8 * q4) * 2); u = MFMA16(a, vtf[ss], u); }
            const f32x4 av = *(const LAS f32x4*)(vec + 128 + 16 * kb + 4 * q4), bv = *(const LAS f32x4*)(vec + 256 + 16 * kb + 4 * q4);
#pragma unroll
            for (int r = 0; r < 4; ++r) S[kb][r] = av[r] * S[kb][r] + bv[r] * u[r]; SCHED_FENCE(); }
        if (FULL) {
#pragma unroll
            for (int tb = 0; tb < 4; ++tb)
#pragma unroll
                for (int r = 0; r < 4; ++r) { float sq = o[tb][r] * o[tb][r]; sq += SHFL_XOR(sq, 1); sq += SHFL_XOR(sq, 2); sq += SHFL_XOR(sq, 4); sq += SHFL_XOR(sq, 8);
                    if (l16 == 0) *(LAS float*)(lds + HG_OSQ + ((16 * tb + 4 * q4 + r) * 8 + w) * 4) = sq; }
            BLOCK_SYNC();
            { const float gv = gout[h * HD + 16 * w + l16];
#pragma unroll
              for (int tb = 0; tb < 4; ++tb)
#pragma unroll
                for (int r = 0; r < 4; ++r) { const int t = 16 * tb + 4 * q4 + r; const f32x4 s0 = *(const LAS f32x4*)(lds + HG_OSQ + t * 32), s1 = *(const LAS f32x4*)(lds + HG_OSQ + t * 32 + 16);
                    const float tot = ((s0[0] + s0[1]) + (s0[2] + s0[3])) + ((s1[0] + s1[1]) + (s1[2] + s1[3]));
                    *(LAS float*)(lds + HG_QM + (t * 132 + 16 * w + l16) * 4) = o[tb][r] * frsq(tot * (1.0f / HD) + EPS) * gv; } }
            BLOCK_SYNC();
            { const int t = tid >> 3, c0 = 16 * (tid & 7); const LAS float* src = (const LAS float*)(lds + HG_QM) + t * 132 + c0;
              const f32x4 a0 = *(const LAS f32x4*)src, a1 = *(const LAS f32x4*)(src + 4), a2 = *(const LAS f32x4*)(src + 8), a3 = *(const LAS f32x4*)(src + 12);
              u32x4 w0, w1;
              w0.x = pk2(a0[0] * bf_lo(cgt[0].x), a0[1] * bf_hi(cgt[0].x)); w0.y = pk2(a0[2] * bf_lo(cgt[0].y), a0[3] * bf_hi(cgt[0].y)); w0.z = pk2(a1[0] * bf_lo(cgt[0].z), a1[1] * bf_hi(cgt[0].z)); w0.w = pk2(a1[2] * bf_lo(cgt[0].w), a1[3] * bf_hi(cgt[0].w));
              w1.x = pk2(a2[0] * bf_lo(cgt[1].x), a2[1] * bf_hi(cgt[1].x)); w1.y = pk2(a2[2] * bf_lo(cgt[1].y), a2[3] * bf_hi(cgt[1].y)); w1.z = pk2(a3[0] * bf_lo(cgt[1].z), a3[1] * bf_hi(cgt[1].z)); w1.w = pk2(a3[2] * bf_lo(cgt[1].w), a3[3] * bf_hi(cgt[1].w));
              bf16_t* op = ob + (size_t)(rowbase + c * CH + t) * D + colo; *(u32x4*)op = w0; *(u32x4*)(op + 8) = w1; }
        }
    }
    if (s_out) { int so = (4 * q4) * HD + 16 * w + l16; OPAQUE(so);
#pragma unroll
        for (int kb = 0; kb < 8; ++kb) {
#pragma unroll
            for (int r = 0; r < 4; ++r) s_out[so + r * HD] = S[kb][r];
            so += 16 * HD; OPAQUE(so); } }
    if (gseg_out && tg == 0) { gseg_out[2 * kp] = gs0; gseg_out[2 * kp + 1] = gs1; }
    BLOCK_SYNC();
}

DEV void hgrn_scan(int gtid, int GT, const float* lseg, const float* gseg, float* sstart) {
    OPAQUE(gtid);
    for (int e = gtid; e < 32 * HD * HD; e += GT) { const int stream = e >> 14, kv = e & 16383, k = kv >> 7; float s = 0.f;
        for (int j = 0; j < NSEG - 1; ++j) { const size_t sj = (size_t)stream * NSEG + j; s = fexp(gseg[sj * HD + k]) * s + lseg[(sj << 14) + kv]; sstart[((sj + 1) << 14) + kv] = s; } }
}

template <int PT>
DEV void cumsum_unit(LAS unsigned char* lds, int tid, const float* a, int na, int sa, const float* b, int sb, int n, float* dst) {
    OPAQUE(tid);
    LAS double* part = (LAS double*)lds; LAS double* grp = part + 512;
    float v[PT]; double loc = 0.0;
#pragma unroll
    for (int i = 0; i < PT; ++i) { const int p = tid * PT + i; v[i] = p < n ? (p < na ? a[(size_t)p * sa] : b[(size_t)(p - na) * sb]) : 0.f; loc += (double)v[i]; }
    part[tid] = loc;
    BLOCK_SYNC();
    double pre = 0.0; const int g0 = tid & ~15;
    for (int j = g0; j < tid; ++j) pre += part[j];
    if ((tid & 15) == 15) grp[tid >> 4] = pre + loc;
    BLOCK_SYNC();
    for (int j = 0; j < (tid >> 4); ++j) pre += grp[j];
#pragma unroll
    for (int i = 0; i < PT; ++i) { const int p = tid * PT + i; pre += (double)v[i]; if (p < n) dst[p] = (float)pre; }
    BLOCK_SYNC();
}

DEV void knorm_unit(int tid, const bf16_t* Kb, int nkeys, unsigned* dst) {
    OPAQUE(tid);
    const int sub = tid & 15, kr = tid >> 4; float mx = 0.f;
    for (int k0 = 0; k0 < nkeys; k0 += 32) { const u32x4 t = *(const u32x4*)(Kb + (size_t)(k0 + kr) * D + sub * 8); float s = 0.f;
#pragma unroll
        for (int e = 0; e < 4; ++e) { const float a = bf_lo(t[e]), b = bf_hi(t[e]); s += a * a + b * b; }
        s += SHFL_XOR(s, 1); s += SHFL_XOR(s, 2); s += SHFL_XOR(s, 4); s += SHFL_XOR(s, 8); mx = fmaxf(mx, s); }
    mx = fmaxf(mx, SHFL_XOR(mx, 16)); mx = fmaxf(mx, SHFL_XOR(mx, 32));
    if ((tid & 63) == 0) ATOMIC_MAX_U32(dst, __builtin_bit_cast(unsigned, mx));
}

constexpr int AT_K = 0, AT_VT = 17408, AT_DK = 35840, AT_FLAG = 36096, AT_END = 36160;
constexpr float PRUNE_T2 = 36.0f;
DEV void attn_block(LAS unsigned char* lds, int tid, const bf16_t* Q, const bf16_t* gate, bf16_t* O, const bf16_t* Kb, const bf16_t* Vb, const float* Dc, int qpos0, int nrows, float kmax) {
    OPAQUE(tid);
    const int lane = tid & 63, w = UNIFORM(tid >> 6), l16 = lane & 15, q4 = lane >> 4, dp = tid & 63, kg = w;
    const bool active = 32 * w < nrows;
    const int ntiles = (qpos0 + nrows + 63) >> 6;
    constexpr float C2 = 0.08838834764831845f * LOG2E;
    bf16x8 Qf[2][4]; float Dq2[2], mrun[2], lrun[2], cb[2]; f32x4 Oa[2][8];
#pragma unroll
    for (int qb = 0; qb < 2; ++qb) { const int r = active ? 32 * w + 16 * qb + l16 : 0;
#pragma unroll
        for (int st = 0; st < 4; ++st) Qf[qb][st] = *(const bf16x8*)(Q + (size_t)r * D + 32 * st + 8 * q4);
        Dq2[qb] = Dc[qpos0 + r] * LOG2E; mrun[qb] = -1e30f; lrun[qb] = 0.f;
        { float q2 = 0.f;
#pragma unroll
          for (int st = 0; st < 4; ++st) { const u32x4 t = __builtin_bit_cast(u32x4, Qf[qb][st]);
#pragma unroll
              for (int e = 0; e < 4; ++e) { const float a = bf_lo(t[e]), b = bf_hi(t[e]); q2 += a * a + b * b; } }
          q2 += SHFL_XOR(q2, 16); q2 += SHFL_XOR(q2, 32); cb[qb] = sqrtf(q2) * kmax * C2 + Dq2[qb]; }
#pragma unroll
        for (int db = 0; db < 8; ++db) Oa[qb][db] = (f32x4){0.f, 0.f, 0.f, 0.f}; }
    u32x4 pk_[2]; unsigned pv[8]; float pd = 0.f;
    const int krow = tid >> 4, kc16 = tid & 15;
#define AT_LOAD(j) do { _Pragma("unroll") for (int i = 0; i < 2; ++i) pk_[i] = *(const u32x4*)(Kb + (size_t)(64 * (j) + krow + 32 * i) * D + kc16 * 8); \
        _Pragma("unroll") for (int i = 0; i < 8; ++i) pv[i] = *(const unsigned*)(Vb + (size_t)(64 * (j) + 8 * kg + i) * D + 2 * dp); \
        if (tid < 64) pd = Dc[64 * (j) + tid] * LOG2E; } while (0)
    AT_LOAD(ntiles - 1);
    const int ks_ = kg >> 2, kq = kg & 3, hb = kq >> 1;
    const int vpos0 = (32 * ks_ + 16 * (kq & 1) + 4 * hb) * 2, vpos1 = vpos0 + 16;
    if (tid < 8) *(LAS unsigned*)(lds + AT_FLAG + tid * 4) = 0u;
    for (int j = ntiles - 1; j >= 0; --j) {
        BLOCK_SYNC();
        { const u32x4 f0 = *(const LAS u32x4*)(lds + AT_FLAG), f1 = *(const LAS u32x4*)(lds + AT_FLAG + 16);
          if (UNIFORM((f0.x & f0.y & f0.z & f0.w & f1.x & f1.y & f1.z & f1.w) != 0u)) break; }
#pragma unroll
        for (int i = 0; i < 2; ++i) *(LAS u32x4*)(lds + AT_K + (krow + 32 * i) * 272 + kc16 * 16) = pk_[i];
        { u32x2 a, b;
          a.x = (pv[0] & 0xffffu) | (pv[1] << 16); a.y = (pv[2] & 0xffffu) | (pv[3] << 16); b.x = (pv[4] & 0xffffu) | (pv[5] << 16); b.y = (pv[6] & 0xffffu) | (pv[7] << 16);
          *(LAS u32x2*)(lds + AT_VT + (2 * dp) * 144 + vpos0) = a; *(LAS u32x2*)(lds + AT_VT + (2 * dp) * 144 + vpos1) = b;
          a.x = (pv[0] >> 16) | (pv[1] & 0xffff0000u); a.y = (pv[2] >> 16) | (pv[3] & 0xffff0000u); b.x = (pv[4] >> 16) | (pv[5] & 0xffff0000u); b.y = (pv[6] >> 16) | (pv[7] & 0xffff0000u);
          *(LAS u32x2*)(lds + AT_VT + (2 * dp + 1) * 144 + vpos0) = a; *(LAS u32x2*)(lds + AT_VT + (2 * dp + 1) * 144 + vpos1) = b; }
        if (tid < 64) *(LAS float*)(lds + AT_DK + tid * 4) = pd;
        BLOCK_SYNC();
        if (j > 0) AT_LOAD(j - 1);
        bool done = true;
        if (active && 64 * j <= qpos0 + 32 * w + 31) {
            f32x4 s[2][4];
#pragma unroll
            for (int kb = 0; kb < 4; ++kb) { bf16x8 kf[4];
#pragma unroll
                for (int st = 0; st < 4; ++st) kf[st] = *(const LAS bf16x8*)(lds + AT_K + (16 * kb + l16) * 272 + (32 * st + 8 * q4) * 2);
#pragma unroll
                for (int qb = 0; qb < 2; ++qb) { f32x4 acc = {0.f, 0.f, 0.f, 0.f};
#pragma unroll
                    for (int st = 0; st < 4; ++st) acc = MFMA16(kf[st], Qf[qb][st], acc);
                    s[qb][kb] = acc; } SCHED_FENCE(); }
            const bool need_mask = 64 * j + 63 > qpos0 + 32 * w;
#pragma unroll
            for (int qb = 0; qb < 2; ++qb) { const int qpos = qpos0 + 32 * w + 16 * qb + l16; float mx = -__builtin_inff();
#pragma unroll
                for (int kb = 0; kb < 4; ++kb) { const f32x4 dk = *(const LAS f32x4*)(lds + AT_DK + (16 * kb + 4 * q4) * 4);
#pragma unroll
                    for (int r = 0; r < 4; ++r) { float v = s[qb][kb][r] * C2 + (Dq2[qb] - dk[r]); if (need_mask && 64 * j + 16 * kb + 4 * q4 + r > qpos) v = -__builtin_inff(); s[qb][kb][r] = v; mx = fmaxf(mx, v); } }
                mx = fmaxf(mx, SHFL_XOR(mx, 16)); mx = fmaxf(mx, SHFL_XOR(mx, 32));
                const float mn = fmaxf(mrun[qb], mx), alpha = fexp2(mrun[qb] - mn); mrun[qb] = mn; float ps = 0.f;
#pragma unroll
                for (int kb = 0; kb < 4; ++kb)
#pragma unroll
                    for (int r = 0; r < 4; ++r) { const float p = fexp2(s[qb][kb][r] - mn); s[qb][kb][r] = p; ps += p; }
                lrun[qb] = lrun[qb] * alpha + ps;
#pragma unroll
                for (int db = 0; db < 8; ++db) Oa[qb][db] = Oa[qb][db] * alpha; }
            bf16x8 pf[2][2];
#pragma unroll
            for (int qb = 0; qb < 2; ++qb)
#pragma unroll
                for (int ks = 0; ks < 2; ++ks) { u32x4 t; t.x = pk2(s[qb][2 * ks][0], s[qb][2 * ks][1]); t.y = pk2(s[qb][2 * ks][2], s[qb][2 * ks][3]); t.z = pk2(s[qb][2 * ks + 1][0], s[qb][2 * ks + 1][1]); t.w = pk2(s[qb][2 * ks + 1][2], s[qb][2 * ks + 1][3]);
                    pf[qb][ks] = __builtin_bit_cast(bf16x8, t); }
#pragma unroll
            for (int db = 0; db < 8; ++db)
#pragma unroll
                for (int ks = 0; ks < 2; ++ks) { const bf16x8 a = *(const LAS bf16x8*)(lds + AT_VT + (16 * db + l16) * 144 + (32 * ks + 8 * q4) * 2);
#pragma unroll
                    for (int qb = 0; qb < 2; ++qb) Oa[qb][db] = MFMA16(a, pf[qb][ks], Oa[qb][db]); if (ks == 1) SCHED_FENCE(); }
        }
        if (active) { const float dk0 = *(const LAS float*)(lds + AT_DK);
            done = (cb[0] - dk0 - mrun[0] < -PRUNE_T2) && (cb[1] - dk0 - mrun[1] < -PRUNE_T2); }
        { const bool wdone = WAVE_ALL(done); if (lane == 0) *(LAS unsigned*)(lds + AT_FLAG + w * 4) = wdone ? 1u : 0u; }
    }
#undef AT_LOAD
    if (active) {
#pragma unroll
        for (int qb = 0; qb < 2; ++qb) { float l = lrun[qb]; l += SHFL_XOR(l, 16); l += SHFL_XOR(l, 32); const float inv = 1.0f / l; const size_t ro = (size_t)(32 * w + 16 * qb + l16) * D;
            u32x2 gt[8];
#pragma unroll
            for (int db = 0; db < 8; ++db) gt[db] = *(const u32x2*)(gate + ro + 16 * db + 4 * q4);
#pragma unroll
            for (int db = 0; db < 8; ++db) { const f32x4 ov = Oa[qb][db] * inv;
                *(u32x2*)(O + ro + 16 * db + 4 * q4) = (u32x2){pk2(ov[0] * bf_lo(gt[db].x), ov[1] * bf_hi(gt[db].x)), pk2(ov[2] * bf_lo(gt[db].y), ov[3] * bf_hi(gt[db].y))}; } }
    }
    BLOCK_SYNC();
}
#ifndef EMU_HOST
#define RLX_AGENT __ATOMIC_RELAXED, __HIP_MEMORY_SCOPE_AGENT
#define LDS_WAIT() asm volatile("s_waitcnt lgkmcnt(0)" ::: "memory")
typedef GAS unsigned gu32;
#define XB_TMO      128
#define XB_XCNT(j)  (256  + 64 * (j))
#define XB_XSUB(j)  (1280 + 64 * (j))
#define XB_XGEN(j)  (2304 + 64 * (j))
#define XB_TOP      3328
#define XB_TOPGEN   3392
#define XCD_BAR_WORDS 3456
#define XB_SPIN_CAP (1u << 18)

__device__ __forceinline__ unsigned xb_ld(unsigned* p)              { return __hip_atomic_load(p, __ATOMIC_RELAXED, __HIP_MEMORY_SCOPE_AGENT); }
__device__ __forceinline__ unsigned xb_add(unsigned* p, unsigned v) { return __hip_atomic_fetch_add(p, v, __ATOMIC_RELAXED, __HIP_MEMORY_SCOPE_AGENT); }
__device__ __forceinline__ unsigned xb_xcc_id() { return (unsigned)__builtin_amdgcn_s_getreg((3 << 11) | 20) & 0xFu; }
#define XB_SPIN(cond, bar) do { unsigned _sp = 0; while (cond) { __builtin_amdgcn_s_sleep(1); \
    if ((++_sp & 255u) == 0u) { if (xb_ld(&(bar)[XB_TMO])) break; if (_sp > XB_SPIN_CAP) { atomicAdd(&(bar)[XB_TMO], 1u); break; } } } } while (0)

struct XcdBarrier {
    unsigned* bar; unsigned x;
    volatile LAS unsigned* st;
};

__device__ __forceinline__ XcdBarrier xcd_barrier_post(unsigned* bar, volatile LAS unsigned* st) {
    XcdBarrier b; b.bar = bar; b.x = xb_xcc_id(); b.st = st;
    if (threadIdx.x == 0) (void)xb_add(&bar[XB_XCNT(b.x)], 1u);
    return b;
}
__device__ __forceinline__ void xcd_barrier_complete(unsigned* bar, unsigned x, unsigned& nloc, unsigned& nx) {
    const unsigned G = gridDim.x * gridDim.y * gridDim.z;
    unsigned sum, cnt, mine, sp = 0u;
    for (;;) {
        sum = 0u; cnt = 0u; mine = 0u;
#pragma unroll
        for (unsigned j = 0; j < 16; ++j) { const unsigned c = xb_ld(&bar[XB_XCNT(j)]); sum += c; cnt += (c > 0u) ? 1u : 0u; mine = (j == x) ? c : mine; }
        if (sum == G) break;
        __builtin_amdgcn_s_sleep(1);
        if ((++sp & 255u) == 0u) { if (xb_ld(&bar[XB_TMO])) break; if (sp > XB_SPIN_CAP) { atomicAdd(&bar[XB_TMO], 1u); break; } }
    }
    nloc = mine > 0u ? mine : 1u; nx = cnt > 0u ? cnt : 1u;
}

__device__ __forceinline__ void xcd_barrier(const XcdBarrier& b) {
    asm volatile("s_waitcnt vmcnt(0)" ::: "memory");
    __syncthreads();
    if (threadIdx.x == 0) {
        unsigned* bar = b.bar;
        __builtin_amdgcn_s_waitcnt(0);
        unsigned nloc = b.st[0], nx = b.st[1];
        if (nloc == 0u) { xcd_barrier_complete(bar, b.x, nloc, nx); b.st[0] = nloc; b.st[1] = nx; }
        const unsigned old = xb_add(&bar[XB_XSUB(b.x)], 1u);
        const unsigned gen = old / nloc;
        if (old + 1u == (gen + 1u) * nloc) {
            __builtin_amdgcn_fence(__ATOMIC_RELEASE, "agent");
            asm volatile("s_waitcnt vmcnt(0)" ::: "memory");
            const unsigned og = xb_add(&bar[XB_TOP], 1u);
            const unsigned tg = og / nx;
            if (og + 1u == (tg + 1u) * nx) xb_add(&bar[XB_TOPGEN], 1u);
            else XB_SPIN(xb_ld(&bar[XB_TOPGEN]) == tg, bar);
            __builtin_amdgcn_fence(__ATOMIC_ACQUIRE, "agent");
            xb_add(&bar[XB_XGEN(b.x)], 1u);
            asm volatile("s_waitcnt vmcnt(0)" ::: "memory");
        } else {
            XB_SPIN(xb_ld(&bar[XB_XGEN(b.x)]) == gen, bar);
            __builtin_amdgcn_fence(__ATOMIC_ACQUIRE, "agent");
            asm volatile("s_waitcnt vmcnt(0)" ::: "memory");
        }
    }
    __syncthreads();
}


__device__ __forceinline__ void p0_transpose_item(const float* W, int K, int N, int pitch, const float* gain, bf16_t* WT, int row_off, LAS float* scr, int item, int lane) {
    const int nblk = N / 32, kb = item / nblk, nb = item % nblk, k0 = 64 * kb, n0 = 32 * nb;
#pragma unroll 8
    for (int i = 0; i < 32; ++i) { const int kk = 2 * i + (lane >> 5); const float gk = gain ? gain[k0 + kk] : 1.0f; scr[kk * 33 + (lane & 31)] = W[(size_t)(k0 + kk) * pitch + n0 + (lane & 31)] * gk; }
    LDS_WAIT(); asm volatile("" ::: "memory");
    const int c = lane & 7;
#pragma unroll
    for (int j = 0; j < 4; ++j) { const int n = (lane >> 3) + 8 * j; const LAS float* s = scr + (8 * c) * 33 + n;
        u32x4 o; o.x = pk2(s[0 * 33], s[1 * 33]); o.y = pk2(s[2 * 33], s[3 * 33]); o.z = pk2(s[4 * 33], s[5 * 33]); o.w = pk2(s[6 * 33], s[7 * 33]);
        *(u32x4*)(WT + (size_t)(row_off + n0 + n) * K + k0 + 8 * c) = o; }
    LDS_WAIT(); asm volatile("" ::: "memory");
}
__device__ __forceinline__ float wave_sum(float v) {
#pragma unroll
    for (int o = 1; o < 64; o <<= 1) v += __shfl_xor(v, o);
    return v;
}

#ifndef SITES
#define SITES 0xFFFF
#endif
#define SITE(k) ((SITES >> (k)) & 1)
#ifndef PROBE_SITES
#define PROBE_SITES 0
#endif
#define NREP(k) (((PROBE_SITES >> (k)) & 1) ? 2 : 1)
struct Args { const float* in[23]; float* out; unsigned char* ws; int ph_lo, ph_hi; };
constexpr int N_PHASES = 26;
__host__ __device__ constexpr bool phase_nonempty(int p) { return !(p == 15 || p == 20 || p == 21); }

__global__ void __launch_bounds__(NWAVES * 64, 2) fwd(Args args) {
    extern __shared__ __attribute__((aligned(16))) unsigned char lds_raw[];
    LAS unsigned char* lds = (LAS unsigned char*)lds_raw;
    volatile LAS unsigned* MISC = (volatile LAS unsigned*)(lds + MISC_OFF);
    const int wave0 = __builtin_amdgcn_readfirstlane(threadIdx.x >> 6);
    const int G = gridDim.x, bx = blockIdx.x, vcu = (G % 8 == 0) ? (bx % 8) * (G / 8) + bx / 8 : bx;
    gu32* ctl = (gu32*)(args.ws + WS_CTL);
    for (int u = threadIdx.x; u < (LDS_BYTES - LDSCTL_OFF) / 4; u += NWAVES * 64) ((LAS unsigned*)(lds + LDSCTL_OFF))[u] = 0u;
    __syncthreads();
    const bool one_launch = (args.ph_lo == 0 && args.ph_hi == N_PHASES);
    XcdBarrier bar; bar.bar = (unsigned*)(ctl + CW_BAR); bar.x = 0; bar.st = nullptr;
    if (one_launch) bar = xcd_barrier_post((unsigned*)(ctl + CW_BAR), MISC + 8);
    const int lo = args.ph_lo, hi = args.ph_hi;
#define IN(k) (lo <= (k) && (k) < hi)
#define SEAM(k) do { if ((k) + 1 < hi) xcd_barrier(bar); } while (0)
#define SITE_FRAME() int tid; asm volatile("v_mbcnt_lo_u32_b32 %0, -1, 0\n\tv_mbcnt_hi_u32_b32 %0, -1, %0" : "=v"(tid)); tid += wave0 * 64; GAS unsigned char* wsb = (GAS unsigned char*)args.ws; asm volatile("" : "+s"(wsb)); \
    const int lane = tid & 63, wave = wave0, gw = vcu * NWAVES + wave, NGW = G * NWAVES, gtid = vcu * (NWAVES * 64) + tid, GT = G * NWAVES * 64; \
    (void)lane; (void)wave; (void)gw; (void)NGW; (void)gtid; (void)GT; (void)wsb
#define x_prompt (args.in[0])
#define x_sample (args.in[1])
#define state_hgrn (args.in[2])
#define cache_k (args.in[3])
#define cache_v (args.in[4])
#define cache_logf (args.in[5])
#define p_prompt (args.in[6])
#define p_sample (args.in[7])
#define g_norm_a (args.in[8])
#define w_in_a (args.in[9])
#define lb_logits (args.in[10])
#define g_out_a (args.in[11])
#define w_out_a (args.in[12])
#define g_kv (args.in[13])
#define w_kv (args.in[14])
#define b_f (args.in[15])
#define g_norm_b (args.in[16])
#define w_in_b (args.in[17])
#define w_out_b (args.in[18])
#define w_ple_in (args.in[19])
#define g_ple (args.in[20])
#define w_ple_gate (args.in[21])
#define g_final (args.in[22])
#define ss ((float*)(wsb + WS_SS))
#define lbv ((float*)(wsb + WS_LBV))
#define gseg ((float*)(wsb + WS_GSEG))
#define Dp ((float*)(wsb + WS_DP))
#define Ds ((float*)(wsb + WS_DS))
#define LF ((float*)(wsb + WS_LF))
#define W_AIN ((bf16_t*)(wsb + WS_WAIN))
#define W_AOUT ((bf16_t*)(wsb + WS_WAOUT))
#define W_KVQ ((bf16_t*)(wsb + WS_WKVQ))
#define W_BIN1 ((bf16_t*)(wsb + WS_WBIN1))
#define W_BOUT ((bf16_t*)(wsb + WS_WBOUT))
#define W_PIN ((bf16_t*)(wsb + WS_WPIN))
#define W_PG ((bf16_t*)(wsb + WS_WPG))
#define X ((float*)(wsb + WS_X))
#define XB ((bf16_t*)(wsb + WS_XB))
#define XB2 ((bf16_t*)(wsb + WS_XB2))
#define ZQ ((bf16_t*)(wsb + WS_ZQ))
#define ZG ((bf16_t*)(wsb + WS_ZG))
#define ZV ((bf16_t*)(wsb + WS_ZV))
#define ZGATE ((bf16_t*)(wsb + WS_ZGATE))
#define OB ((bf16_t*)(wsb + WS_OB))
#define EB ((bf16_t*)(wsb + WS_EB))
#define PB ((bf16_t*)(wsb + WS_PB))
#define KS ((bf16_t*)(wsb + WS_KS))
#define VS ((bf16_t*)(wsb + WS_VS))
#define KP ((bf16_t*)(wsb + WS_KP))
#define VP ((bf16_t*)(wsb + WS_VP))
#define LSEG ((float*)(wsb + WS_LSEG))
#define SSTART ((float*)(wsb + WS_SSTART))
#define out (args.out)
    if (SITE(10) && IN(0)) { SITE_FRAME();
        for (int rep = 0; rep < NREP(10); ++rep) {
        LAS float* scr = (LAS float*)(lds + wave * 16384);
        constexpr int I_AIN = 32 * 256, I_SQ = 32 * 64, I_KV = 32 * 128, I_PIN = 4 * 64;
        constexpr int NITEMS = 2 * I_AIN + 2 * I_SQ + 3 * I_KV + 2 * I_SQ + 4 * I_PIN + 4 * I_SQ;
        for (int it = gw; it < NITEMS; it += NGW) {
            int r = it;
            if (r < 2 * I_AIN) { const int l = r / I_AIN; p0_transpose_item(w_in_a + (size_t)l * D * 4 * D, D, 4 * D, 4 * D, g_norm_a + l * D, W_AIN + (size_t)l * 4 * D * D, 0, scr, r % I_AIN, lane); continue; } r -= 2 * I_AIN;
            if (r < 2 * I_SQ) { const int l = r / I_SQ; p0_transpose_item(w_out_a + (size_t)l * D * D, D, D, D, nullptr, W_AOUT + (size_t)l * D * D, 0, scr, r % I_SQ, lane); continue; } r -= 2 * I_SQ;
            if (r < I_KV) { p0_transpose_item(w_kv, D, 2 * D, 2 * D + H, g_kv, W_KVQ, 0, scr, r, lane); continue; } r -= I_KV;
            if (r < I_KV) { p0_transpose_item(w_in_b, D, 2 * D, 2 * D, g_norm_b, W_KVQ, 2 * D, scr, r, lane); continue; } r -= I_KV;
            if (r < I_KV) { p0_transpose_item(w_in_b + (size_t)D * 2 * D, D, 2 * D, 2 * D, g_norm_b + D, W_BIN1, 0, scr, r, lane); continue; } r -= I_KV;
            if (r < 2 * I_SQ) { const int l = r / I_SQ; p0_transpose_item(w_out_b + (size_t)l * D * D, D, D, D, nullptr, W_BOUT + (size_t)l * D * D, 0, scr, r % I_SQ, lane); continue; } r -= 2 * I_SQ;
            if (r < 4 * I_PIN) { const int l = r / I_PIN; p0_transpose_item(w_ple_in + (size_t)l * DPLE * D, DPLE, D, D, nullptr, W_PIN + (size_t)l * D * DPLE, 0, scr, r % I_PIN, lane); continue; } r -= 4 * I_PIN;
            { const int l = r / I_SQ; p0_transpose_item(w_ple_gate + (size_t)l * D * D, D, D, D, g_ple + l * D, W_PG + (size_t)l * D * D, 0, scr, r % I_SQ, lane); }
        }
        for (int e = gtid; e < 256 * D; e += GT) { const int n = e / D, k = e % D; W_KVQ[(size_t)(4 * D + n) * D + k] = n < H ? (bf16_t)(pk2(g_kv[k] * w_kv[(size_t)k * (2 * D + H) + 2 * D + n], 0.f) & 0xffffu) : (bf16_t)0; }
        for (int m = gw; m < M; m += NGW) { const float* xr = m < MP ? x_prompt + (size_t)m * D : x_sample + (size_t)(m - MP) * D; float s = 0.f;
#pragma unroll
            for (int j = 0; j < 8; ++j) { const f32x4 v = *(const f32x4*)(xr + 256 * j + 4 * lane); s += (v[0] * v[0] + v[1] * v[1]) + (v[2] * v[2] + v[3] * v[3]);
                *(u32x2*)(XB + (size_t)m * D + 256 * j + 4 * lane) = (u32x2){pk2(v[0], v[1]), pk2(v[2], v[3])}; }
            s = wave_sum(s); if (lane == 0) ss[m] = s; }
        for (size_t e = (size_t)gtid * 8; e < (size_t)4 * M * DPLE; e += (size_t)GT * 8) { const int l = (int)(e / ((size_t)M * DPLE)); const size_t r = e % ((size_t)M * DPLE); const int m = (int)(r / DPLE), c = (int)(r % DPLE);
            const float* src = m < MP ? p_prompt + ((size_t)l * MP + m) * DPLE + c : p_sample + ((size_t)l * MS + (m - MP)) * DPLE + c;
            const f32x4 a = *(const f32x4*)src, b = *(const f32x4*)(src + 4); *(u32x4*)(PB + e) = (u32x4){pk2(a[0], a[1]), pk2(a[2], a[3]), pk2(b[0], b[1]), pk2(b[2], b[3])}; }
        for (size_t e = (size_t)gtid * 8; e < (size_t)NBS * PAST * D; e += (size_t)GT * 8) { const size_t r = e / D; const int c = (int)(e % D); const size_t b = r / PAST, pos = r % PAST; const size_t d = (b * LKS + pos) * D + c;
            { const f32x4 a = *(const f32x4*)(cache_k + e), bb = *(const f32x4*)(cache_k + e + 4); *(u32x4*)(KS + d) = (u32x4){pk2(a[0], a[1]), pk2(a[2], a[3]), pk2(bb[0], bb[1]), pk2(bb[2], bb[3])}; }
            { const f32x4 a = *(const f32x4*)(cache_v + e), bb = *(const f32x4*)(cache_v + e + 4); *(u32x4*)(VS + d) = (u32x4){pk2(a[0], a[1]), pk2(a[2], a[3]), pk2(bb[0], bb[1]), pk2(bb[2], bb[3])}; } }
        for (int c = gtid; c < D; c += GT) { lbv[c] = 0.f; lbv[D + c] = 1.0f / (1.0f + expf(lb_logits[c] - lb_logits[D + c])); }
        }
        SEAM(0);
    }

#pragma unroll 1
    for (int L = 0; L < 4; ++L) {
        const int pb = 1 + 6 * L; const bool isA = L < 2; const int j = L - 2;
        if (IN(pb)) { SITE_FRAME();
            if (SITE(0) && isA) for (int rep = 0; rep < NREP(0); ++rep) { pg8::Gemm g{XB, W_AIN + (size_t)L * 4 * D * D, M, 4 * D, D}; pg8::StaticOrder S; S.init(M, 4 * D, G, bx);
                pg8::EpiAin E{ss + (size_t)(2 * L) * M, lbv + L * D, ZQ, ZG, ZV, ZGATE};
                pg8::gemm_phase<pg8::EpiAin, pg8::StaticOrder, true, true>(lds, g, S, E, wave0);
            } else if (SITE(1) && !isA) for (int rep = 0; rep < NREP(1); ++rep) { const int N = (j == 0) ? NKVQ : 2 * D; pg8::Gemm g{XB, j == 0 ? W_KVQ : W_BIN1, M, N, D}; pg8::StaticOrder S; S.init(M, N, G, bx);
                pg8::EpiBin E{ss + (size_t)(2 * L) * M, j == 0 ? 0 : 2, KP, VP, KS, VS, ZQ, ZGATE, out, LF, b_f};
                pg8::gemm_phase<pg8::EpiBin, pg8::StaticOrder, true, true>(lds, g, S, E, wave0); }
            if (SITE(2)) for (int rep = 0; rep < NREP(2); ++rep) { int kple = DPLE; asm volatile("" : "+s"(kple));
              pg8::Gemm g{PB + (size_t)L * M * DPLE, W_PIN + (size_t)L * D * DPLE, M, D, kple}; pg8::StaticOrder S; S.init(M, D, G, bx);
              pg8::EpiBf16 E{EB, D};
              pg8::gemm_phase<pg8::EpiBf16, pg8::StaticOrder, true, true>(lds, g, S, E, wave0); }
            SEAM(pb);
        }
        if (IN(pb + 1) && phase_nonempty(pb + 1)) { SITE_FRAME();
            if (SITE(3) && isA) for (int rep = 0; rep < NREP(3); ++rep) {
                for (int u = vcu; u < 32 * (NSEG - 1); u += G) { const int stream = u / (NSEG - 1), seg = u % (NSEG - 1), b = stream >> 4, h = stream & 15;
                    hgrn_unit<false>(lds, tid, nullptr, ZG, ZV, nullptr, nullptr, nullptr, b * TP + seg * (SEGC * CH), SEGC, h, nullptr, LSEG + ((size_t)(stream * NSEG + seg) << 14), gseg + (size_t)(stream * NSEG + seg) * HD); }
            } else if (SITE(4) && !isA) for (int rep = 0; rep < NREP(4); ++rep) {
                for (int u = vcu; u < 512 + 256; u += G) {
                    if (u < 512) { const int bh = u >> 4, c = u & 15, b = bh >> 4, h = bh & 15; knorm_unit(tid, KP + ((size_t)b * TP + c * 1024) * D + h * HD, 1024, (unsigned*)(wsb + WS_CTL) + CW_KMAX + bh); }
                    else { const int v = u - 512, b = v >> 4, h = v & 15; knorm_unit(tid, KS + (size_t)b * LKS * D + h * HD, LKS, (unsigned*)(wsb + WS_CTL) + CW_KMAX + 32 + v); } }
                for (int u = vcu; u < 32 + 256; u += G) {
                    if (u < 32) { const int b = u >> 4, h = u & 15; cumsum_unit<32>(lds, tid, LF + (size_t)b * TP * H + h, TP, H, nullptr, 0, TP, Dp + (size_t)u * TP); }
                    else { const int v = u - 32, b = v >> 4, h = v & 15; cumsum_unit<3>(lds, tid, cache_logf + (size_t)b * PAST * H + h, PAST, H, LF + (size_t)(MP + b * TS) * H + h, H, LKS, Ds + (size_t)v * LKS); } }
            }
            SEAM(pb + 1);
        }
        if (SITE(5) && IN(pb + 2) && phase_nonempty(pb + 2)) { SITE_FRAME(); for (int rep = 0; rep < NREP(5); ++rep) hgrn_scan(gtid, GT, LSEG, gseg, SSTART); SEAM(pb + 2); }
        if (IN(pb + 3)) { SITE_FRAME();
            if (SITE(6) && isA) for (int rep = 0; rep < NREP(6); ++rep) {
                for (int u = vcu; u < 32 * NSEG + NBS * H; u += G) {
                    if (u < 32 * NSEG) { const int stream = u / NSEG, seg = u % NSEG, b = stream >> 4, h = stream & 15;
                        hgrn_unit<true>(lds, tid, ZQ, ZG, ZV, ZGATE, g_out_a + L * D, OB, b * TP + seg * (SEGC * CH), SEGC, h, seg ? SSTART + ((size_t)(stream * NSEG + seg) << 14) : nullptr,
                                        seg == NSEG - 1 ? out + O_STP + ((size_t)(L * NBP * H + stream) << 14) : nullptr, nullptr); }
                    else { const int v = u - 32 * NSEG, b = v >> 4, h = v & 15;
                        hgrn_unit<true>(lds, tid, ZQ, ZG, ZV, ZGATE, g_out_a + L * D, OB, MP + b * TS, 1, h, state_hgrn + ((size_t)(L * NBS * H + v) << 14), out + O_STS + ((size_t)(L * NBS * H + v) << 14), nullptr); } }
            } else if (SITE(7) && !isA) for (int rep = 0; rep < NREP(7); ++rep) {
                const float* kmx = (const float*)(wsb + WS_CTL) + CW_KMAX;
                for (int u = vcu; u < 2048 + 256; u += G) {
                    if (u < 2048) { const int bh = u >> 6, qb = u & 63, b = bh >> 4, h = bh & 15; const size_t co = (size_t)h * HD, r0 = (size_t)b * TP + 256 * qb;
                        attn_block(lds, tid, ZQ + r0 * D + co, ZGATE + r0 * D + co, OB + r0 * D + co, KP + (size_t)b * TP * D + co, VP + (size_t)b * TP * D + co, Dp + (size_t)bh * TP, 256 * qb, 256, sqrtf(kmx[bh])); }
                    else { const int v = u - 2048, b = v >> 4, h = v & 15; const size_t co = (size_t)h * HD, r0 = (size_t)MP + b * TS;
                        attn_block(lds, tid, ZQ + r0 * D + co, ZGATE + r0 * D + co, OB + r0 * D + co, KS + (size_t)b * LKS * D + co, VS + (size_t)b * LKS * D + co, Ds + (size_t)v * LKS, PAST, TS, sqrtf(kmx[32 + v])); } }
            }
            SEAM(pb + 3);
        }
        if (SITE(8) && IN(pb + 4)) { SITE_FRAME(); pg8::Gemm g{OB, (isA ? W_AOUT + (size_t)L * D * D : W_BOUT + (size_t)j * D * D), M, D, D}; pg8::StaticOrder S; S.init(M, D, G, bx);
            pg8::EpiRes<false> E{L == 0 ? x_prompt : X, L == 0 ? x_sample : X + (size_t)MP * D, X, X + (size_t)MP * D, XB2, ss + (size_t)(2 * L + 1) * M, nullptr, nullptr};
            pg8::gemm_phase<pg8::EpiRes<false>, pg8::StaticOrder, true, true>(lds, g, S, E, wave0);
            SEAM(pb + 4); }
        if (SITE(9) && IN(pb + 5)) { SITE_FRAME(); pg8::Gemm g{XB2, W_PG + (size_t)L * D * D, M, D, D}; pg8::StaticOrder S; S.init(M, D, G, bx);
            pg8::EpiRes<true> E{X, X + (size_t)MP * D, L == 3 ? out + O_YP : X, L == 3 ? out + O_YS : X + (size_t)MP * D, XB, ss + (size_t)(2 * L + 2) * M, ss + (size_t)(2 * L + 1) * M, EB};
            pg8::gemm_phase<pg8::EpiRes<true>, pg8::StaticOrder, true, true>(lds, g, S, E, wave0);
            SEAM(pb + 5); }
    }
    if (SITE(11) && IN(25)) { SITE_FRAME();
        const float* s8 = ss + (size_t)8 * M;
        for (int m = gw; m < M; m += NGW) { float* yr = out + O_YP + (size_t)m * D; const float rstd = frsq(s8[m] * (1.0f / D) + EPS);
#pragma unroll
            for (int jj = 0; jj < 8; ++jj) { const int c = 256 * jj + 4 * lane; const f32x4 v = *(const f32x4*)(yr + c), gv = *(const f32x4*)(g_final + c); *(f32x4*)(yr + c) = v * rstd * gv; } }
    }
#undef IN
#undef SEAM
}
#undef x_prompt
#undef x_sample
#undef state_hgrn
#undef cache_k
#undef cache_v
#undef cache_logf
#undef p_prompt
#undef p_sample
#undef g_norm_a
#undef w_in_a
#undef lb_logits
#undef g_out_a
#undef w_out_a
#undef g_kv
#undef w_kv
#undef b_f
#undef g_norm_b
#undef w_in_b
#undef w_out_b
#undef w_ple_in
#undef g_ple
#undef w_ple_gate
#undef g_final
#undef ss
#undef lbv
#undef gseg
#undef Dp
#undef Ds
#undef LF
#undef W_AIN
#undef W_AOUT
#undef W_KVQ
#undef W_BIN1
#undef W_BOUT
#undef W_PIN
#undef W_PG
#undef X
#undef XB
#undef XB2
#undef ZQ
#undef ZG
#undef ZV
#undef ZGATE
#undef OB
#undef EB
#undef PB
#undef KS
#undef VS
#undef KP
#undef VP
#undef LSEG
#undef SSTART
#undef out

extern "C" void kernel_launch(void* const* d_in, const int* in_sizes, int n_in, void* d_out, int out_size, void* d_ws, size_t ws_size, hipStream_t stream) {
    static int grid = 0;
    if (grid == 0) {
        if (n_in != 23 || (size_t)out_size != O_END || ws_size < WS_END) { fprintf(stderr, "kernel_launch: unexpected shapes (n_in %d, out %d, ws %zu); nothing launched\n", n_in, out_size, ws_size); grid = -1; return; }
        int dev = 0, cus = 0, per_cu = 0;
        if (hipGetDevice(&dev) != hipSuccess || hipDeviceGetAttribute(&cus, hipDeviceAttributeMultiprocessorCount, dev) != hipSuccess) { grid = -1; return; }
        if (hipFuncSetAttribute((const void*)fwd, hipFuncAttributeMaxDynamicSharedMemorySize, LDS_BYTES) != hipSuccess) { fprintf(stderr, "kernel_launch: hipFuncSetAttribute failed\n"); grid = -1; return; }
        if (hipOccupancyMaxActiveBlocksPerMultiprocessor(&per_cu, (const void*)fwd, NWAVES * 64, LDS_BYTES) != hipSuccess || per_cu < 1) { fprintf(stderr, "kernel_launch: occupancy query says %d\n", per_cu); }
        (void)hipGetLastError();
        grid = cus;
    }
    if (grid < 0) return;
    (void)hipMemsetAsync((char*)d_ws + WS_CTL, 0, CTL_ZERO_BYTES, stream);
    Args a{};
    for (int i = 0; i < 23; ++i) a.in[i] = (const float*)d_in[i];
    a.out = (float*)d_out; a.ws = (unsigned char*)d_ws;
#ifndef MK_PER_PHASE
    a.ph_lo = 0; a.ph_hi = N_PHASES;
    hipLaunchKernelGGL(fwd, dim3(grid), dim3(NWAVES * 64), LDS_BYTES, stream, a);
#else
    for (int p = 0; p < N_PHASES; ++p) { if (!phase_nonempty(p)) continue; a.ph_lo = p; a.ph_hi = p + 1; hipLaunchKernelGGL(fwd, dim3(grid), dim3(NWAVES * 64), LDS_BYTES, stream, a); }
#endif
}
#endif
```

```cpp
#ifndef EMU_HOST
#include <hip/hip_runtime.h>
#endif
#include <cstdio>
#include <cstdint>

constexpr int D = 2048, H = 16, HD = 128, DPLE = 256;
constexpr int NBP = 2, TP = 16384, MP = NBP * TP;
constexpr int NBS = 16, TS = 64, MS = NBS * TS;
constexpr int M = MP + MS;
constexpr int PAST = 1024, LKS = PAST + TS;
constexpr int NSEG = 16, SEGC = 16, CH = 64;
constexpr int NKVQ = 8448;
constexpr float EPS = 1e-6f;
constexpr float LOG2E = 1.4426950408889634f;

constexpr size_t O_YP = 0, O_YS = O_YP + (size_t)MP * D, O_STP = O_YS + (size_t)MS * D, O_STS = O_STP + (size_t)2 * NBP * H * HD * HD,
                 O_KP = O_STS + (size_t)2 * NBS * H * HD * HD, O_VP = O_KP + (size_t)MP * D, O_LFP = O_VP + (size_t)MP * D, O_KS = O_LFP + (size_t)MP * H,
                 O_VS = O_KS + (size_t)MS * D, O_LFS = O_VS + (size_t)MS * D, O_END = O_LFS + (size_t)MS * H;
static_assert(O_END == 217595904ull, "output size");

constexpr size_t MiB = 1u << 20;
constexpr size_t WS_CTL = 0, CTL_ZERO_BYTES = 3 * MiB;
constexpr size_t WS_SS = 1 * MiB;
constexpr size_t WS_LBV = 3 * MiB;
constexpr size_t WS_GSEG = 3 * MiB + 64 * 1024;
constexpr size_t WS_DP = 4 * MiB, WS_DS = 6 * MiB, WS_LF = 8 * MiB;
constexpr size_t WS_WAIN = 12 * MiB, WS_WAOUT = 76 * MiB, WS_WKVQ = 92 * MiB, WS_WBIN1 = 125 * MiB, WS_WBOUT = 141 * MiB, WS_WPIN = 157 * MiB, WS_WPG = 161 * MiB;
constexpr size_t WS_X = 193 * MiB, WS_XB = 457 * MiB, WS_ZQ = 589 * MiB, WS_ZG = 721 * MiB, WS_ZV = 853 * MiB, WS_ZGATE = 985 * MiB, WS_OB = 1117 * MiB, WS_EB = 1249 * MiB;
constexpr size_t WS_PB = 1381 * MiB, WS_KS = 1447 * MiB, WS_VS = 1515 * MiB, WS_LSEG = 1583 * MiB, WS_SSTART = 1615 * MiB, WS_XB2 = 1647 * MiB, WS_END = 1779 * MiB;
constexpr size_t WS_KP = WS_ZG, WS_VP = WS_ZV;
static_assert(WS_SS + 9ull * M * 4 <= CTL_ZERO_BYTES && (size_t)M * D * 2 == 132 * MiB && (size_t)NKVQ * D * 2 <= 33 * MiB && (size_t)NBS * LKS * D * 2 <= 68 * MiB, "ws map");
constexpr int CW_TMO = 0, CW_BAR = 4096, CW_KMAX = 8192;

constexpr int RING_BYTES = 131072, LDSCTL_OFF = RING_BYTES, MISC_OFF = LDSCTL_OFF + 320, LDS_BYTES = 147456, NWAVES = 8;

typedef unsigned short bf16_t;
typedef short bf16x8 __attribute__((ext_vector_type(8)));
typedef float f32x4 __attribute__((ext_vector_type(4)));
typedef float f32x2 __attribute__((ext_vector_type(2)));
typedef unsigned u32x4 __attribute__((ext_vector_type(4)));
typedef unsigned u32x2 __attribute__((ext_vector_type(2)));
typedef _Float16 h16x2 __attribute__((ext_vector_type(2)));

#ifndef EMU_HOST
#define DEV __device__ __forceinline__
#define GAS __attribute__((address_space(1)))
#define LAS __attribute__((address_space(3)))
#define BLOCK_SYNC() __syncthreads()
#define SHFL_XOR(v, m) __shfl_xor((v), (m))
#define MFMA16(a, b, c) __builtin_amdgcn_mfma_f32_16x16x32_bf16((a), (b), (c), 0, 0, 0)
#define ATOMIC_ADD_F32(p, v) ((void)__hip_atomic_fetch_add((p), (v), __ATOMIC_RELAXED, __HIP_MEMORY_SCOPE_AGENT))
#define ATOMIC_MAX_U32(p, v) ((void)__hip_atomic_fetch_max((p), (v), __ATOMIC_RELAXED, __HIP_MEMORY_SCOPE_AGENT))
DEV float fexp(float x) { return __expf(x); }
DEV float fexp2(float x) { return __builtin_amdgcn_exp2f(x); }
DEV float flog(float x) { return __logf(x); }
DEV float frcp(float x) { return __builtin_amdgcn_rcpf(x); }
DEV float frsq(float x) { return __builtin_amdgcn_rsqf(x); }
DEV unsigned pk2(float lo, float hi) { unsigned r; asm volatile("v_cvt_pk_bf16_f32 %0, %1, %2" : "=v"(r) : "v"(lo), "v"(hi)); return r; }
#endif
DEV float bf_lo(unsigned w) { return __builtin_bit_cast(float, w << 16); }
DEV float bf_hi(unsigned w) { return __builtin_bit_cast(float, w & 0xffff0000u); }
DEV float bf2f(bf16_t b) { return __builtin_bit_cast(float, (unsigned)b << 16); }
DEV unsigned pkh2(float lo, float hi) { h16x2 t = {(_Float16)lo, (_Float16)hi}; return __builtin_bit_cast(unsigned, t); }
DEV float h_lo(unsigned w) { h16x2 t = __builtin_bit_cast(h16x2, w); return (float)t.x; }
DEV float h_hi(unsigned w) { h16x2 t = __builtin_bit_cast(h16x2, w); return (float)t.y; }
DEV float sigmoidf_(float z) { return frcp(1.0f + fexp(-z)); }
DEV float siluf_(float z) { return z * frcp(1.0f + fexp(-z)); }

#ifndef EMU_HOST
namespace pg8 {
#define PG8_LAS __attribute__((address_space(3)))
typedef unsigned short bf16_t;
typedef short bf16x8 __attribute__((ext_vector_type(8)));
typedef float f32x4 __attribute__((ext_vector_type(4)));
typedef unsigned u32x4 __attribute__((ext_vector_type(4)));
constexpr int BM = 256, BK = 64, HALF = 128, HTB = HALF * BK * 2  , STAGE_BYTES = 8 * HTB, NXCD = 8, WGM = 8;

__host__ __device__ __forceinline__ int lds_byte(int r, int c) { const int st = (r >> 4) * 2 + (c >> 5), rr = r & 15, cc = c & 31, ob = rr * 64 + cc * 2; return st * 1024 + (ob ^ (((ob >> 9) & 1) << 5)); }
__host__ __device__ __forceinline__ void stage_rc(int b, int& R, int& C) { const int st = b / 1024, sb = b % 1024, swz = sb ^ (((sb >> 9) & 1) << 5); R = (st >> 1) * 16 + swz / 64; C = (st & 1) * 32 + (swz % 64) / 2; }
__host__ __device__ __forceinline__ int perm32(int rho) { const int n = rho >> 4, i = rho & 15; return 8 * (i >> 2) + 4 * n + (i & 3); }

struct Unit { int pm, pn; };
struct Gemm { const bf16_t* A; const bf16_t* Bt; int M, N, K; };

struct StaticOrder {
    int nM, nN, nwg, G, c;
    __host__ __device__ void init(int M, int N, int G_, int c_) { nM = M / BM; nN = N / BM; nwg = nM * nN; G = G_; c = c_; }
    __host__ __device__ bool next(int i, Unit& u) const {
        const long L = (long)i * G + c; if (L >= nwg) return false;
        int wgid = (int)L; { const int q = nwg / NXCD, r = nwg % NXCD, xcd = wgid % NXCD, off = wgid / NXCD; wgid = (xcd < r ? xcd * (q + 1) : r * (q + 1) + (xcd - r) * q) + off; }
        const int nig = WGM * nN, gid = wgid / nig, fm = gid * WGM, gsz = (nM - fm) < WGM ? (nM - fm) : WGM;
        u.pm = fm + ((wgid % nig) % gsz); u.pn = (wgid % nig) / gsz; return true;
    }
    __device__ __forceinline__ void a_ready(const Unit&) const {}
    __device__ __forceinline__ void done(const Unit&) const {}
};

__device__ __forceinline__ unsigned cvt_pk_bf16(float lo, float hi) { unsigned r; asm volatile("v_cvt_pk_bf16_f32 %0, %1, %2" : "=v"(r) : "v"(lo), "v"(hi)); return r; }
typedef float f32x2 __attribute__((ext_vector_type(2)));

__device__ __forceinline__ void zero_acc(f32x4 (&acc)[2][2][4][2]) {
#pragma unroll
    for (int a = 0; a < 2; ++a)
#pragma unroll
        for (int b = 0; b < 2; ++b)
#pragma unroll
            for (int m = 0; m < 4; ++m)
#pragma unroll
                for (int n = 0; n < 2; ++n) acc[a][b][m][n] = (f32x4){0.f, 0.f, 0.f, 0.f};
}
struct EpiBf16 {
    static constexpr bool PERM = true, AFTER_DRAIN = false;
    bf16_t* O; int ldc;
    __device__ __forceinline__ void init(f32x4 (&acc)[2][2][4][2], const Unit&, int, int, int, int) const { zero_acc(acc); }
    __device__ __forceinline__ void operator()(const f32x4 (&acc)[2][2][4][2], const Unit& u, int wr, int wc, int fr, int fq) const {
        const int row0 = u.pm * BM + wr * 64 + fr, col0 = u.pn * BM + wc * 32 + 8 * fq;
#pragma unroll
        for (int ai = 0; ai < 2; ++ai)
#pragma unroll
            for (int m = 0; m < 4; ++m) { bf16_t* rowp = O + (size_t)(row0 + ai * HALF + m * 16) * ldc + col0;
#pragma unroll
                for (int bj = 0; bj < 2; ++bj) { const f32x4 v0 = acc[ai][bj][m][0], v1 = acc[ai][bj][m][1];
                    u32x4 w; w.x = cvt_pk_bf16(v0[0], v0[1]); w.y = cvt_pk_bf16(v0[2], v0[3]); w.z = cvt_pk_bf16(v1[0], v1[1]); w.w = cvt_pk_bf16(v1[2], v1[3]);
                    *(u32x4*)(rowp + bj * HALF) = w; } }
    }
};

struct EpiAin {
    static constexpr bool PERM = true, AFTER_DRAIN = false;
    const float* ss; const float* lb; bf16_t* zq; bf16_t* zg; bf16_t* zv; bf16_t* zgate;
    __device__ __forceinline__ void init(f32x4 (&acc)[2][2][4][2], const Unit&, int, int, int, int) const { zero_acc(acc); }
    template <int TYPE> __device__ __forceinline__ void run(const f32x4 (&acc)[2][2][4][2], const Unit& u, int wr, int wc, int fr, int fq, bf16_t* base) const {
        const int ct = (u.pn & 7) * BM + wc * 32 + 8 * fq, row0 = u.pm * BM + wr * 64 + fr;
        const int hc = wc * 32 + 8 * fq; const size_t hrow = (size_t)((u.pn & 7) * 2) * M;
        float rs[8];
#pragma unroll
        for (int i = 0; i < 8; ++i) rs[i] = ss[row0 + (i >> 2) * HALF + (i & 3) * 16];
#pragma unroll
        for (int ai = 0; ai < 2; ++ai)
#pragma unroll
            for (int m = 0; m < 4; ++m) { const int row = row0 + ai * HALF + m * 16; const float rstd = frsq(rs[ai * 4 + m] * (1.0f / D) + EPS);
                bf16_t* rowp = base + (hrow + row) * HD + hc;
#pragma unroll
                for (int bj = 0; bj < 2; ++bj) { f32x4 v0 = acc[ai][bj][m][0] * rstd, v1 = acc[ai][bj][m][1] * rstd; u32x4 w;
                    if (TYPE == 1) {
                        const f32x4 l0 = *(const f32x4*)(lb + ct + bj * HALF), l1 = *(const f32x4*)(lb + ct + bj * HALF + 4);
#pragma unroll
                        for (int j = 0; j < 4; ++j) { v0[j] = fmaxf(flog(l0[j] + (1.0f - l0[j]) * sigmoidf_(v0[j])), -80.0f); v1[j] = fmaxf(flog(l1[j] + (1.0f - l1[j]) * sigmoidf_(v1[j])), -80.0f); }
                        w.x = pkh2(v0[0], v0[1]); w.y = pkh2(v0[2], v0[3]); w.z = pkh2(v1[0], v1[1]); w.w = pkh2(v1[2], v1[3]);
                    } else {
                        if (TYPE == 0) {
#pragma unroll
                            for (int j = 0; j < 4; ++j) { v0[j] = siluf_(v0[j]); v1[j] = siluf_(v1[j]); } }
                        w.x = cvt_pk_bf16(v0[0], v0[1]); w.y = cvt_pk_bf16(v0[2], v0[3]); w.z = cvt_pk_bf16(v1[0], v1[1]); w.w = cvt_pk_bf16(v1[2], v1[3]);
                    }
                    *(u32x4*)(rowp + (size_t)bj * M * HD) = w; } }
    }
    __device__ __forceinline__ void operator()(const f32x4 (&acc)[2][2][4][2], const Unit& u, int wr, int wc, int fr, int fq) const {
        const int type = u.pn >> 3;
        if (type == 0) run<0>(acc, u, wr, wc, fr, fq, zq); else if (type == 1) run<1>(acc, u, wr, wc, fr, fq, zg); else if (type == 2) run<2>(acc, u, wr, wc, fr, fq, zv); else run<0>(acc, u, wr, wc, fr, fq, zgate);
    }
};

struct EpiBin {
    static constexpr bool PERM = true, AFTER_DRAIN = false;
    const float* ss; int tbase; bf16_t* kp; bf16_t* vp; bf16_t* ks; bf16_t* vs; bf16_t* zq; bf16_t* zgate; float* out; float* lf; const float* bf;
    __device__ __forceinline__ void init(f32x4 (&acc)[2][2][4][2], const Unit&, int, int, int, int) const { zero_acc(acc); }
    template <int TYPE> __device__ __forceinline__ void run(const f32x4 (&acc)[2][2][4][2], const Unit& u, int wr, int wc, int fr, int fq) const {
        const int ct = (u.pn & 7) * BM + wc * 32 + 8 * fq, row0 = u.pm * BM + wr * 64 + fr; const bool smp = u.pm >= MP / BM;
        float rs[8];
#pragma unroll
        for (int i = 0; i < 8; ++i) rs[i] = ss[row0 + (i >> 2) * HALF + (i & 3) * 16];
#pragma unroll
        for (int ai = 0; ai < 2; ++ai)
#pragma unroll
            for (int m = 0; m < 4; ++m) { const int row = row0 + ai * HALF + m * 16; const float rstd = frsq(rs[ai * 4 + m] * (1.0f / D) + EPS);
                const int ms = row - MP;
                if (TYPE == 4) {
                    if (wc == 0 && fq < 2) { const f32x4 v0 = acc[ai][0][m][0] * rstd + *(const f32x4*)(bf + 8 * fq), v1 = acc[ai][0][m][1] * rstd + *(const f32x4*)(bf + 8 * fq + 4); f32x4 r0, r1;
#pragma unroll
                        for (int j = 0; j < 4; ++j) { r0[j] = fminf(v0[j], 0.f) - log1pf(expf(-fabsf(v0[j]))); r1[j] = fminf(v1[j], 0.f) - log1pf(expf(-fabsf(v1[j]))); }
                        float* o = smp ? out + O_LFS + (size_t)ms * H + 8 * fq : out + O_LFP + (size_t)row * H + 8 * fq; float* l = lf + (size_t)row * H + 8 * fq;
                        *(f32x4*)o = r0; *(f32x4*)(o + 4) = r1; *(f32x4*)l = r0; *(f32x4*)(l + 4) = r1; }
                } else {
                    bf16_t* rowp; float* orow = nullptr; size_t hstride;
                    const int hc = wc * 32 + 8 * fq, h0 = (u.pn & 7) * 2;
                    if (TYPE == 0 || TYPE == 1) {
                        if (smp) { const size_t kr = (size_t)(ms / TS) * LKS + PAST + (ms % TS); hstride = (size_t)NBS * LKS * HD; rowp = (TYPE == 0 ? ks : vs) + h0 * hstride + kr * HD + hc; orow = out + (TYPE == 0 ? O_KS : O_VS) + (size_t)ms * D + ct; }
                        else { hstride = (size_t)MP * HD; rowp = (TYPE == 0 ? kp : vp) + h0 * hstride + (size_t)row * HD + hc; orow = out + (TYPE == 0 ? O_KP : O_VP) + (size_t)row * D + ct; }
                    } else { hstride = (size_t)M * HD; rowp = (TYPE == 2 ? zq : zgate) + h0 * hstride + (size_t)row * HD + hc; }
#pragma unroll
                    for (int bj = 0; bj < 2; ++bj) { f32x4 v0 = acc[ai][bj][m][0] * rstd, v1 = acc[ai][bj][m][1] * rstd;
                        if (TYPE == 0 || TYPE == 1) { *(f32x4*)(orow + bj * HALF) = v0; *(f32x4*)(orow + bj * HALF + 4) = v1; }
                        if (TYPE == 3) {
#pragma unroll
                            for (int j = 0; j < 4; ++j) { v0[j] = siluf_(v0[j]); v1[j] = siluf_(v1[j]); } }
                        u32x4 w; w.x = cvt_pk_bf16(v0[0], v0[1]); w.y = cvt_pk_bf16(v0[2], v0[3]); w.z = cvt_pk_bf16(v1[0], v1[1]); w.w = cvt_pk_bf16(v1[2], v1[3]);
                        *(u32x4*)(rowp + bj * hstride) = w; }
                } }
    }
    __device__ __forceinline__ void operator()(const f32x4 (&acc)[2][2][4][2], const Unit& u, int wr, int wc, int fr, int fq) const {
        const int type = (u.pn >> 3) + tbase;
        if (type == 0) run<0>(acc, u, wr, wc, fr, fq); else if (type == 1) run<1>(acc, u, wr, wc, fr, fq); else if (type == 2) run<2>(acc, u, wr, wc, fr, fq); else if (type == 3) run<3>(acc, u, wr, wc, fr, fq); else run<4>(acc, u, wr, wc, fr, fq);
    }
};

template <bool PLE> struct EpiRes {
    static constexpr bool PERM = false, AFTER_DRAIN = false;
    const float* xin_p; const float* xin_s; float* xout_p; float* xout_s; bf16_t* xb; float* ss_out; const float* ss_in; const bf16_t* e;
    __device__ __forceinline__ void init(f32x4 (&acc)[2][2][4][2], const Unit& u, int wr, int wc, int fr, int fq) const {
        if (PLE) { zero_acc(acc); return; }
        const int row0 = u.pm * BM + wr * 64 + fr, col0 = u.pn * BM + wc * 32 + 4 * fq; const bool smp = u.pm >= MP / BM;
        const float* xi = (smp ? xin_s : xin_p) + (size_t)(row0 - (smp ? MP : 0)) * D + col0;
#pragma unroll
        for (int ai = 0; ai < 2; ++ai)
#pragma unroll
            for (int m = 0; m < 4; ++m)
#pragma unroll
                for (int bj = 0; bj < 2; ++bj)
#pragma unroll
                    for (int n = 0; n < 2; ++n) acc[ai][bj][m][n] = *(const f32x4*)(xi + (size_t)(ai * HALF + m * 16) * D + bj * HALF + n * 16);
    }
    __device__ __forceinline__ void operator()(const f32x4 (&acc)[2][2][4][2], const Unit& u, int wr, int wc, int fr, int fq) const {
        const int row0 = u.pm * BM + wr * 64 + fr, col0 = u.pn * BM + wc * 32 + 4 * fq; const bool smp = u.pm >= MP / BM;
        const float* xi = (smp ? xin_s : xin_p) + (size_t)(row0 - (smp ? MP : 0)) * D + col0; float* xo = (smp ? xout_s : xout_p) + (size_t)(row0 - (smp ? MP : 0)) * D + col0;
        bf16_t* xbp = xb + (size_t)row0 * D + col0; const bf16_t* ep = e + (size_t)row0 * D + col0;
        float sacc[8], rs[8];
        if (PLE) {
#pragma unroll
            for (int i = 0; i < 8; ++i) rs[i] = ss_in[row0 + (i >> 2) * HALF + (i & 3) * 16]; }
#pragma unroll
        for (int ai = 0; ai < 2; ++ai)
#pragma unroll
            for (int mp = 0; mp < 2; ++mp) {
                f32x4 xv[2][2][2]; u32x2 ev[2][2][2];
                if (PLE) {
#pragma unroll
                    for (int mm = 0; mm < 2; ++mm)
#pragma unroll
                        for (int bj = 0; bj < 2; ++bj)
#pragma unroll
                            for (int n = 0; n < 2; ++n) { const size_t o = (size_t)(ai * HALF + (2 * mp + mm) * 16) * D + bj * HALF + n * 16; xv[mm][bj][n] = *(const f32x4*)(xi + o); ev[mm][bj][n] = *(const u32x2*)(ep + o); } }
#pragma unroll
                for (int mm = 0; mm < 2; ++mm) { const int m = 2 * mp + mm; float rstd = 1.f; if (PLE) rstd = frsq(rs[ai * 4 + m] * (1.0f / D) + EPS); float s = 0.f;
#pragma unroll
                    for (int bj = 0; bj < 2; ++bj)
#pragma unroll
                        for (int n = 0; n < 2; ++n) { const size_t o = (size_t)(ai * HALF + m * 16) * D + bj * HALF + n * 16; f32x4 xn = acc[ai][bj][m][n];
                            if (PLE) { const f32x4 a = xn * rstd; const u32x2 w = ev[mm][bj][n];
                                xn[0] = xv[mm][bj][n][0] + sigmoidf_(a[0]) * bf_lo(w.x); xn[1] = xv[mm][bj][n][1] + sigmoidf_(a[1]) * bf_hi(w.x); xn[2] = xv[mm][bj][n][2] + sigmoidf_(a[2]) * bf_lo(w.y); xn[3] = xv[mm][bj][n][3] + sigmoidf_(a[3]) * bf_hi(w.y); }
                            *(f32x4*)(xo + o) = xn;
                            u32x2 wb; wb.x = cvt_pk_bf16(xn[0], xn[1]); wb.y = cvt_pk_bf16(xn[2], xn[3]); *(u32x2*)(xbp + o) = wb;
                            s += (xn[0] * xn[0] + xn[1] * xn[1]) + (xn[2] * xn[2] + xn[3] * xn[3]); }
                    s += __shfl_xor(s, 16); s += __shfl_xor(s, 32); sacc[ai * 4 + m] = s; } }
#pragma unroll
        for (int j = 0; j < 2; ++j) { const float v = fq == 0 ? sacc[4 * j] : fq == 1 ? sacc[4 * j + 1] : fq == 2 ? sacc[4 * j + 2] : sacc[4 * j + 3];
            __hip_atomic_fetch_add(ss_out + row0 + j * HALF + fq * 16, v, __ATOMIC_RELAXED, __HIP_MEMORY_SCOPE_AGENT); }
    }
};

template <class Epi, class Sched, bool ALIGN_EPI = false, bool SP2 = false>
__device__ __forceinline__ void gemm_phase(PG8_LAS unsigned char* lds, const Gemm g, const Sched& S, const Epi& E, const int wave_in) {
    int tid_; asm volatile("v_mbcnt_lo_u32_b32 %0, -1, 0\n\tv_mbcnt_hi_u32_b32 %0, -1, %0" : "=v"(tid_)); tid_ += wave_in * 64;
    const int tid = tid_, wid = __builtin_amdgcn_readfirstlane(tid >> 6), lane = tid & 63, wr = wid >> 2, wc = wid & 3, fr = lane & 15, fq = lane >> 4;
    const int K = g.K, nt = K / BK;
    unsigned voffA[2], voffB[2];
#pragma unroll
    for (int i = 0; i < 2; ++i) { int R, C; stage_rc(tid * 16 + i * 8192, R, C); const int Rb = Epi::PERM ? ((R & ~31) + perm32(R & 31)) : R;
        voffA[i] = (unsigned)(R * K + C) * 2u; voffB[i] = (unsigned)(Rb * K + C) * 2u; }
    const size_t kstep = (size_t)(BK * 2);
    const size_t hstep = (size_t)HALF * K * 2;
    const size_t tstep = 2 * hstep;
    const unsigned ldsw = (unsigned)wid * 1024u;
    const int aoff = lds_byte(wr * 64 + fr, fq * 8), boff = lds_byte(wc * 32 + fr, fq * 8);
#define PG8_SA(b, h) (((b) * 2 + (h)) * HTB)
#define PG8_SB(b, h) ((4 + (b) * 2 + (h)) * HTB)
#define PG8_STAGE(bufoff, gbase, voff) do { _Pragma("unroll") for (int _i = 0; _i < 2; ++_i) \
        __builtin_amdgcn_global_load_lds((const unsigned*)((const char*)(gbase) + (voff)[_i]), (PG8_LAS unsigned*)(lds + (bufoff) + ldsw + _i * 8192), 16, 0, 0); } while (0)
#define PG8_LDA(dst, b, h) do { _Pragma("unroll") for (int m = 0; m < 4; ++m) _Pragma("unroll") for (int k = 0; k < 2; ++k) dst[m][k] = *(const PG8_LAS bf16x8*)(lds + PG8_SA(b, h) + aoff + m * 2048 + k * 1024); } while (0)
#define PG8_LDB(dst, b, h) do { _Pragma("unroll") for (int n = 0; n < 2; ++n) _Pragma("unroll") for (int k = 0; k < 2; ++k) dst[n][k] = *(const PG8_LAS bf16x8*)(lds + PG8_SB(b, h) + boff + n * 2048 + k * 1024); } while (0)
#define PG8_MMA(ai, bj, At, Bt) do { __builtin_amdgcn_s_setprio(1); _Pragma("unroll") for (int m = 0; m < 4; ++m) _Pragma("unroll") for (int n = 0; n < 2; ++n) _Pragma("unroll") for (int k = 0; k < 2; ++k) \
        acc[ai][bj][m][n] = __builtin_amdgcn_mfma_f32_16x16x32_bf16(Bt[n][k], At[m][k], acc[ai][bj][m][n], 0, 0, 0); __builtin_amdgcn_s_setprio(0); } while (0)
#define PG8_WAIT_V(n) asm volatile("s_waitcnt vmcnt(" #n ")" ::: "memory")
#define PG8_WAIT_L(n) asm volatile("s_waitcnt lgkmcnt(" #n ")" ::: "memory")
#define PG8_BAR __builtin_amdgcn_s_barrier()
#define PG8_SCHED __builtin_amdgcn_sched_barrier(0)
    Unit cur, nxt; int ui = 0;
    if (!S.next(0, cur)) return;
    f32x4 acc[2][2][4][2];
    E.init(acc, cur, wr, wc, fr, fq);
    bf16x8 At[4][2], B0[2][2], B1[2][2];
    const char* cA = (const char*)g.A + (size_t)cur.pm * tstep; const char* cB = (const char*)g.Bt + (size_t)cur.pn * tstep;
    S.a_ready(cur);
    if constexpr (SP2) {
        PG8_STAGE(PG8_SB(0, 0), cB, voffB); PG8_STAGE(PG8_SB(0, 1), cB + hstep, voffB); PG8_STAGE(PG8_SA(0, 0), cA, voffA); PG8_STAGE(PG8_SA(0, 1), cA + hstep, voffA);
        if (wr == 1) PG8_BAR;
        PG8_WAIT_V(2); PG8_BAR;
        PG8_STAGE(PG8_SB(1, 0), cB + kstep, voffB); PG8_STAGE(PG8_SA(1, 0), cA + kstep, voffA); PG8_STAGE(PG8_SB(1, 1), cB + hstep + kstep, voffB);
        PG8_WAIT_V(6); PG8_BAR;
    } else {
        PG8_STAGE(PG8_SB(0, 0), cB, voffB); PG8_STAGE(PG8_SA(0, 0), cA, voffA); PG8_STAGE(PG8_SB(0, 1), cB + hstep, voffB); PG8_STAGE(PG8_SA(0, 1), cA + hstep, voffA);
        if (wr == 1) PG8_BAR;
        PG8_WAIT_V(4); PG8_BAR;
        PG8_STAGE(PG8_SB(1, 0), cB + kstep, voffB); PG8_STAGE(PG8_SA(1, 0), cA + kstep, voffA); PG8_STAGE(PG8_SB(1, 1), cB + hstep + kstep, voffB);
        PG8_WAIT_V(6); PG8_BAR;
    }
    for (;;) {
        const bool has_next = S.next(ui + 1, nxt);
        const char* nA = has_next ? (const char*)g.A + (size_t)nxt.pm * tstep : cA; const char* nB = has_next ? (const char*)g.Bt + (size_t)nxt.pn * tstep : cB;
        for (int t = 0; t < nt; t += 2) {
            const bool last = (t == nt - 2);
            const char* a1 = cA + (size_t)(t + 1) * kstep;
            const char* a2 = last ? nA : cA + (size_t)(t + 2) * kstep; const char* b2 = last ? nB : cB + (size_t)(t + 2) * kstep;
            const char* a3 = a2 + kstep; const char* b3 = b2 + kstep;
            if (last && has_next) S.a_ready(nxt);
            if constexpr (SP2) {
            PG8_LDB(B0, 0, 0); PG8_LDB(B1, 0, 1); PG8_SCHED; PG8_LDA(At, 0, 0); PG8_STAGE(PG8_SA(1, 1), a1 + hstep, voffA);
            PG8_WAIT_V(8); PG8_WAIT_L(0); PG8_BAR; PG8_MMA(0, 0, At, B0); PG8_MMA(0, 1, At, B1); PG8_BAR; PG8_SCHED;
            PG8_LDA(At, 0, 1); PG8_STAGE(PG8_SB(0, 0), b2, voffB); PG8_STAGE(PG8_SB(0, 1), b2 + hstep, voffB); PG8_STAGE(PG8_SA(0, 0), a2, voffA);
            PG8_WAIT_V(8); PG8_WAIT_L(0); PG8_BAR; PG8_MMA(1, 0, At, B0); PG8_MMA(1, 1, At, B1); PG8_BAR; PG8_SCHED;
            PG8_LDB(B0, 1, 0); PG8_LDB(B1, 1, 1); PG8_SCHED; PG8_LDA(At, 1, 0); PG8_STAGE(PG8_SA(0, 1), a2 + hstep, voffA);
            PG8_WAIT_V(8); PG8_WAIT_L(0); PG8_BAR; PG8_MMA(0, 0, At, B0); PG8_MMA(0, 1, At, B1); PG8_BAR; PG8_SCHED;
            PG8_LDA(At, 1, 1); PG8_STAGE(PG8_SB(1, 0), b3, voffB); PG8_STAGE(PG8_SB(1, 1), b3 + hstep, voffB); PG8_STAGE(PG8_SA(1, 0), a3, voffA);
            PG8_WAIT_V(8); PG8_WAIT_L(0); PG8_BAR; PG8_MMA(1, 0, At, B0); PG8_MMA(1, 1, At, B1); PG8_BAR; PG8_SCHED;
            } else {
            PG8_LDB(B0, 0, 0); PG8_SCHED; PG8_LDA(At, 0, 0); PG8_STAGE(PG8_SA(1, 1), a1 + hstep, voffA);
            PG8_WAIT_L(8); PG8_BAR; PG8_WAIT_L(0); PG8_MMA(0, 0, At, B0); PG8_BAR; PG8_SCHED;
            PG8_LDB(B1, 0, 1); PG8_STAGE(PG8_SB(0, 0), b2, voffB);
            PG8_BAR; PG8_WAIT_L(0); PG8_MMA(0, 1, At, B1); PG8_BAR;
            PG8_LDA(At, 0, 1); PG8_STAGE(PG8_SA(0, 0), a2, voffA);
            PG8_BAR; PG8_WAIT_L(0); PG8_MMA(1, 0, At, B0); PG8_BAR; PG8_SCHED;
            PG8_STAGE(PG8_SB(0, 1), b2 + hstep, voffB);
            PG8_WAIT_V(6); PG8_BAR; PG8_MMA(1, 1, At, B1); PG8_BAR;
            PG8_LDB(B0, 1, 0); PG8_SCHED; PG8_LDA(At, 1, 0); PG8_STAGE(PG8_SA(0, 1), a2 + hstep, voffA);
            PG8_WAIT_L(8); PG8_BAR; PG8_WAIT_L(0); PG8_MMA(0, 0, At, B0); PG8_BAR; PG8_SCHED;
            PG8_LDB(B1, 1, 1); PG8_STAGE(PG8_SB(1, 0), b3, voffB);
            PG8_BAR; PG8_WAIT_L(0); PG8_MMA(0, 1, At, B1); PG8_BAR;
            PG8_LDA(At, 1, 1); PG8_STAGE(PG8_SA(1, 0), a3, voffA);
            PG8_BAR; PG8_WAIT_L(0); PG8_MMA(1, 0, At, B0); PG8_BAR; PG8_SCHED;
            PG8_STAGE(PG8_SB(1, 1), b3 + hstep, voffB);
            PG8_WAIT_V(6); PG8_BAR; PG8_MMA(1, 1, At, B1); PG8_BAR;
            }
        }
        if constexpr (ALIGN_EPI) { if (wr == 0) PG8_BAR; }
        if constexpr (!Epi::AFTER_DRAIN) { E(acc, cur, wr, wc, fr, fq); S.done(cur); }
        if (!has_next) break;
        E.init(acc, nxt, wr, wc, fr, fq);
        cur = nxt; cA = nA; cB = nB; ++ui;
        if constexpr (ALIGN_EPI) { if (wr == 1) PG8_BAR; }
    }
    PG8_WAIT_V(0);
    if constexpr (!ALIGN_EPI) { if (wr == 0) PG8_BAR; }
    PG8_BAR;
    if constexpr (Epi::AFTER_DRAIN) { E.fused(acc, cur, wr, wc, fr, fq, lds, wid, lane); S.done(cur); }
#undef PG8_SA
#undef PG8_SB
#undef PG8_STAGE
#undef PG8_LDA
#undef PG8_LDB
#undef PG8_MMA
#undef PG8_WAIT_V
#undef PG8_WAIT_L
#undef PG8_BAR
#undef PG8_SCHED
}
}
#endif
#ifndef EMU_HOST
#define SCHED_FENCE() __builtin_amdgcn_sched_barrier(0)
#define OPAQUE(v) asm volatile("" : "+v"(v))
#define UNIFORM(x) __builtin_amdgcn_readfirstlane(x)
#define WAVE_ALL(p) (__all(p) != 0)
#else
#define SCHED_FENCE() do {} while (0)
#define OPAQUE(v) do {} while (0)
#define UNIFORM(x) (x)
#define WAVE_ALL(p) (p)
#endif
constexpr int HG_QM = 0, HG_KM = 17408, HG_KMT = 34816, HG_VT = 53248, HG_A = 71680, HG_VEC = 80896, HG_GSUM = 82432, HG_OSQ = 86528, HG_END = 88576;
static_assert(HG_END <= RING_BYTES, "HGRN LDS");

template <bool FULL>
DEV void hgrn_unit(LAS unsigned char* lds, int tid, const bf16_t* zq, const bf16_t* zg, const bf16_t* zv, const bf16_t* zgate, const float* gout, bf16_t* ob,
                   int rowbase, int nchunks, int h, const float* s_init, float* s_out, float* gseg_out) {
    OPAQUE(tid);
    const int lane = tid & 63, w = UNIFORM(tid >> 6), l16 = lane & 15, q4 = lane >> 4, kp = tid & 63, tg = w;
    f32x4 S[8];
    { int so = (4 * q4) * HD + 16 * w + l16;
#pragma unroll
      for (int kb = 0; kb < 8; ++kb) {
#pragma unroll
        for (int r = 0; r < 4; ++r) S[kb][r] = s_init ? s_init[so + r * HD] : 0.f;
        so += 16 * HD; OPAQUE(so); } }
    unsigned pq[8], pg[8], pv[8];
    const int colq = 2 * kp, colo = 16 * (tid & 7);
#pragma unroll
    for (int i = 0; i < 8; ++i) { const size_t o = (size_t)(rowbase + 8 * tg + i) * HD + colq; pg[i] = *(const unsigned*)(zg + o); pv[i] = *(const unsigned*)(zv + o); if (FULL) pq[i] = *(const unsigned*)(zq + o); }
    unsigned pg2[8], pv2[8];
    if (!FULL && nchunks > 1) {
#pragma unroll
        for (int i = 0; i < 8; ++i) { const size_t o = (size_t)(rowbase + CH + 8 * tg + i) * HD + colq; pg2[i] = *(const unsigned*)(zg + o); pv2[i] = *(const unsigned*)(zv + o); } }
    float gv_out = 0.f; if (FULL) gv_out = gout[h * HD + 16 * w + l16];
    float gs0 = 0.f, gs1 = 0.f;
    for (int c = 0; c < nchunks; ++c) {
        float G0[8], G1[8], g0[8], g1[8];
        { float c0 = 0.f, c1 = 0.f;
#pragma unroll
          for (int i = 0; i < 8; ++i) { g0[i] = h_lo(pg[i]); g1[i] = h_hi(pg[i]); c0 += g0[i]; c1 += g1[i]; G0[i] = c0; G1[i] = c1; }
          *(LAS f32x2*)(lds + HG_GSUM + (tg * 128 + 2 * kp) * 4) = (f32x2){c0, c1}; }
        BLOCK_SYNC();
        float P0 = 0.f, P1 = 0.f, T0 = 0.f, T1 = 0.f, M0 = 0.f, M1 = 0.f;
#pragma unroll
        for (int j = 0; j < 8; ++j) { const f32x2 s = *(const LAS f32x2*)(lds + HG_GSUM + (j * 128 + 2 * kp) * 4); if (j < tg) { P0 += s.x; P1 += s.y; } if (j < 4) { M0 += s.x; M1 += s.y; } T0 += s.x; T1 += s.y; }
        unsigned kmw[8];
#pragma unroll
        for (int i = 0; i < 8; ++i) { const int t = 8 * tg + i; const float Gt0 = P0 + G0[i], Gt1 = P1 + G1[i];
            const float ek0 = fexp(fminf(M0 - Gt0, 80.f)), ek1 = fexp(fminf(M1 - Gt1, 80.f));
            kmw[i] = pk2((1.f - fexp(g0[i])) * ek0, (1.f - fexp(g1[i])) * ek1);
            if (FULL) { const float eq0 = fexp(fminf(Gt0 - M0, 80.f)), eq1 = fexp(fminf(Gt1 - M1, 80.f));
                *(LAS unsigned*)(lds + HG_QM + t * 272 + 4 * kp) = pk2(bf_lo(pq[i]) * eq0, bf_hi(pq[i]) * eq1);
                *(LAS unsigned*)(lds + HG_KM + t * 272 + 4 * kp) = kmw[i]; } }
        { u32x4 a, b;
          a.x = (kmw[0] & 0xffffu) | (kmw[1] << 16); a.y = (kmw[2] & 0xffffu) | (kmw[3] << 16); a.z = (kmw[4] & 0xffffu) | (kmw[5] << 16); a.w = (kmw[6] & 0xffffu) | (kmw[7] << 16);
          b.x = (kmw[0] >> 16) | (kmw[1] & 0xffff0000u); b.y = (kmw[2] >> 16) | (kmw[3] & 0xffff0000u); b.z = (kmw[4] >> 16) | (kmw[5] & 0xffff0000u); b.w = (kmw[6] >> 16) | (kmw[7] & 0xffff0000u);
          *(LAS u32x4*)(lds + HG_KMT + (2 * kp) * 144 + tg * 16) = a; *(LAS u32x4*)(lds + HG_KMT + (2 * kp + 1) * 144 + tg * 16) = b;
          a.x = (pv[0] & 0xffffu) | (pv[1] << 16); a.y = (pv[2] & 0xffffu) | (pv[3] << 16); a.z = (pv[4] & 0xffffu) | (pv[5] << 16); a.w = (pv[6] & 0xffffu) | (pv[7] << 16);
          b.x = (pv[0] >> 16) | (pv[1] & 0xffff0000u); b.y = (pv[2] >> 16) | (pv[3] & 0xffff0000u); b.z = (pv[4] >> 16) | (pv[5] & 0xffff0000u); b.w = (pv[6] >> 16) | (pv[7] & 0xffff0000u);
          *(LAS u32x4*)(lds + HG_VT + (2 * kp) * 144 + tg * 16) = a; *(LAS u32x4*)(lds + HG_VT + (2 * kp + 1) * 144 + tg * 16) = b; }
        if (tg == 0) { LAS float* vec = (LAS float*)(lds + HG_VEC);
            *(LAS f32x2*)(vec + 2 * kp) = (f32x2){fexp(M0), fexp(M1)}; *(LAS f32x2*)(vec + 128 + 2 * kp) = (f32x2){fexp(T0), fexp(T1)}; *(LAS f32x2*)(vec + 256 + 2 * kp) = (f32x2){fexp(T0 - M0), fexp(T1 - M1)};
            gs0 += T0; gs1 += T1; }
        if (FULL) { if (c + 1 < nchunks) {
#pragma unroll
            for (int i = 0; i < 8; ++i) { const size_t o = (size_t)(rowbase + (c + 1) * CH + 8 * tg + i) * HD + colq; pg[i] = *(const unsigned*)(zg + o); pv[i] = *(const unsigned*)(zv + o); pq[i] = *(const unsigned*)(zq + o); } }
        } else {
#pragma unroll
            for (int i = 0; i < 8; ++i) { pg[i] = pg2[i]; pv[i] = pv2[i]; }
            if (c + 2 < nchunks) {
#pragma unroll
                for (int i = 0; i < 8; ++i) { const size_t o = (size_t)(rowbase + (c + 2) * CH + 8 * tg + i) * HD + colq; pg2[i] = *(const unsigned*)(zg + o); pv2[i] = *(const unsigned*)(zv + o); } } }
        BLOCK_SYNC();
        u32x4 cgt[2];
        if (FULL) { const bf16_t* gp = zgate + (size_t)(rowbase + c * CH + (tid >> 3)) * HD + colo; cgt[0] = *(const u32x4*)gp; cgt[1] = *(const u32x4*)(gp + 8); }
        if (FULL) { const int tb = w & 3;
#pragma unroll
            for (int sbi = 0; sbi < 2; ++sbi) { const int sb = 2 * (w >> 2) + sbi;
                if (sb <= tb) { f32x4 acc = {0.f, 0.f, 0.f, 0.f};
#pragma unroll
                    for (int st = 0; st < 4; ++st) { const bf16x8 a = *(const LAS bf16x8*)(lds + HG_KM + (16 * sb + l16) * 272 + (32 * st + 8 * q4) * 2), b = *(const LAS bf16x8*)(lds + HG_QM + (16 * tb + l16) * 272 + (32 * st + 8 * q4) * 2);
                        acc = MFMA16(a, b, acc); }
                    if (sb == tb) {
#pragma unroll
                        for (int r = 0; r < 4; ++r) if (4 * q4 + r > l16) acc[r] = 0.f; }
                    *(LAS u32x2*)(lds + HG_A + (16 * tb + l16) * 144 + (16 * sb + 4 * q4) * 2) = (u32x2){pk2(acc[0], acc[1]), pk2(acc[2], acc[3])};
                } else if ((sb >> 1) <= (tb >> 1)) *(LAS u32x2*)(lds + HG_A + (16 * tb + l16) * 144 + (16 * sb + 4 * q4) * 2) = (u32x2){0u, 0u};
            }
            BLOCK_SYNC(); }
        const LAS float* vec = (const LAS float*)(lds + HG_VEC);
        bf16x8 vtf[2];
#pragma unroll
        for (int ss = 0; ss < 2; ++ss) vtf[ss] = *(const LAS bf16x8*)(lds + HG_VT + (16 * w + l16) * 144 + (32 * ss + 8 * q4) * 2);
        f32x4 o[4];
        if (FULL) {
            bf16x8 bfr[4];
#pragma unroll
            for (int j = 0; j < 4; ++j) { const f32x4 e0 = *(const LAS f32x4*)(vec + 32 * j + 4 * q4), e1 = *(const LAS f32x4*)(vec + 32 * j + 16 + 4 * q4);
                u32x4 t; t.x = pk2(S[2 * j][0] * e0[0], S[2 * j][1] * e0[1]); t.y = pk2(S[2 * j][2] * e0[2], S[2 * j][3] * e0[3]); t.z = pk2(S[2 * j + 1][0] * e1[0], S[2 * j + 1][1] * e1[1]); t.w = pk2(S[2 * j + 1][2] * e1[2], S[2 * j + 1][3] * e1[3]);
                bfr[j] = __builtin_bit_cast(bf16x8, t); }
#pragma unroll
            for (int tb = 0; tb < 4; ++tb) { f32x4 acc = {0.f, 0.f, 0.f, 0.f};
                u32x2 qa[4][2]; bf16x8 aa[2];
#pragma unroll
                for (int j = 0; j < 4; ++j) { qa[j][0] = *(const LAS u32x2*)(lds + HG_QM + (16 * tb + l16) * 272 + (32 * j + 4 * q4) * 2); qa[j][1] = *(const LAS u32x2*)(lds + HG_QM + (16 * tb + l16) * 272 + (32 * j + 16 + 4 * q4) * 2); }
#pragma unroll
                for (int ss = 0; ss < 2; ++ss) if (ss == 0 || tb >= 2) aa[ss] = *(const LAS bf16x8*)(lds + HG_A + (16 * tb + l16) * 144 + (32 * ss + 8 * q4) * 2);
#pragma unroll
                for (int j = 0; j < 4; ++j) { const u32x4 t = {qa[j][0].x, qa[j][0].y, qa[j][1].x, qa[j][1].y}; acc = MFMA16(__builtin_bit_cast(bf16x8, t), bfr[j], acc); }
#pragma unroll
                for (int ss = 0; ss < 2; ++ss) if (ss == 0 || tb >= 2) acc = MFMA16(aa[ss], vtf[ss], acc);
                o[tb] = acc; SCHED_FENCE(); }
        }
#pragma unroll
        for (int kb = 0; kb < 8; ++kb) { f32x4 u = {0.f, 0.f, 0.f, 0.f};
            const bf16x8 k0 = *(const LAS bf16x8*)(lds + HG_KMT + (16 * kb + l16) * 144 + (8 * q4) * 2), k1 = *(const LAS bf16x8*)(lds + HG_KMT + (16 * kb + l16) * 144 + (32 + 8 * q4) * 2);
            const f32x4 av = *(const LAS f32x4*)(vec + 128 + 16 * kb + 4 * q4), bv = *(const LAS f32x4*)(vec + 256 + 16 * kb + 4 * q4);
            u = MFMA16(k0, vtf[0], u); u = MFMA16(k1, vtf[1], u);
#pragma unroll
            for (int r = 0; r < 4; ++r) S[kb][r] = av[r] * S[kb][r] + bv[r] * u[r]; if (kb & 1) SCHED_FENCE(); }
        if (FULL) {
#pragma unroll
            for (int tb = 0; tb < 4; ++tb)
#pragma unroll
                for (int r = 0; r < 4; ++r) { float sq = o[tb][r] * o[tb][r]; sq += SHFL_XOR(sq, 1); sq += SHFL_XOR(sq, 2); sq += SHFL_XOR(sq, 4); sq += SHFL_XOR(sq, 8);
                    if (l16 == 0) *(LAS float*)(lds + HG_OSQ + ((16 * tb + 4 * q4 + r) * 8 + w) * 4) = sq; }
            BLOCK_SYNC();
            { const float gv = gv_out;
#pragma unroll
              for (int tb = 0; tb < 4; ++tb)
#pragma unroll
                for (int r = 0; r < 4; ++r) { const int t = 16 * tb + 4 * q4 + r; const f32x4 s0 = *(const LAS f32x4*)(lds + HG_OSQ + t * 32), s1 = *(const LAS f32x4*)(lds + HG_OSQ + t * 32 + 16);
                    const float tot = ((s0[0] + s0[1]) + (s0[2] + s0[3])) + ((s1[0] + s1[1]) + (s1[2] + s1[3]));
                    *(LAS float*)(lds + HG_QM + (t * 132 + 16 * w + l16) * 4) = o[tb][r] * frsq(tot * (1.0f / HD) + EPS) * gv; } }
            BLOCK_SYNC();
            { const int t = tid >> 3, c0 = 16 * (tid & 7); const LAS float* src = (const LAS float*)(lds + HG_QM) + t * 132 + c0;
              const f32x4 a0 = *(const LAS f32x4*)src, a1 = *(const LAS f32x4*)(src + 4), a2 = *(const LAS f32x4*)(src + 8), a3 = *(const LAS f32x4*)(src + 12);
              u32x4 w0, w1;
              w0.x = pk2(a0[0] * bf_lo(cgt[0].x), a0[1] * bf_hi(cgt[0].x)); w0.y = pk2(a0[2] * bf_lo(cgt[0].y), a0[3] * bf_hi(cgt[0].y)); w0.z = pk2(a1[0] * bf_lo(cgt[0].z), a1[1] * bf_hi(cgt[0].z)); w0.w = pk2(a1[2] * bf_lo(cgt[0].w), a1[3] * bf_hi(cgt[0].w));
              w1.x = pk2(a2[0] * bf_lo(cgt[1].x), a2[1] * bf_hi(cgt[1].x)); w1.y = pk2(a2[2] * bf_lo(cgt[1].y), a2[3] * bf_hi(cgt[1].y)); w1.z = pk2(a3[0] * bf_lo(cgt[1].z), a3[1] * bf_hi(cgt[1].z)); w1.w = pk2(a3[2] * bf_lo(cgt[1].w), a3[3] * bf_hi(cgt[1].w));
              bf16_t* op = ob + (size_t)(rowbase + c * CH + t) * D + h * HD + colo; *(u32x4*)op = w0; *(u32x4*)(op + 8) = w1; }
        }
    }
    if (s_out) { int so = (4 * q4) * HD + 16 * w + l16; OPAQUE(so);
#pragma unroll
        for (int kb = 0; kb < 8; ++kb) {
#pragma unroll
            for (int r = 0; r < 4; ++r) s_out[so + r * HD] = S[kb][r];
            so += 16 * HD; OPAQUE(so); } }
    if (gseg_out && tg == 0) { gseg_out[2 * kp] = gs0; gseg_out[2 * kp + 1] = gs1; }
    BLOCK_SYNC();
}

DEV void hgrn_scan(int gtid, int GT, const float* lseg, const float* gseg, float* sstart) {
    OPAQUE(gtid);
    for (int e = gtid; e < 32 * HD * HD; e += GT) { const int stream = e >> 14, kv = e & 16383, k = kv >> 7; float s = 0.f;
        for (int j = 0; j < NSEG - 1; ++j) { const size_t sj = (size_t)stream * NSEG + j; s = fexp(gseg[sj * HD + k]) * s + lseg[(sj << 14) + kv]; sstart[((sj + 1) << 14) + kv] = s; } }
}

template <int PT>
DEV void cumsum_unit(LAS unsigned char* lds, int tid, const float* a, int na, int sa, const float* b, int sb, int n, float* dst) {
    OPAQUE(tid);
    LAS double* part = (LAS double*)lds; LAS double* grp = part + 512;
    float v[PT]; double loc = 0.0;
#pragma unroll
    for (int i = 0; i < PT; ++i) { const int p = tid * PT + i; v[i] = p < n ? (p < na ? a[(size_t)p * sa] : b[(size_t)(p - na) * sb]) : 0.f; loc += (double)v[i]; }
    part[tid] = loc;
    BLOCK_SYNC();
    double pre = 0.0; const int g0 = tid & ~15;
    for (int j = g0; j < tid; ++j) pre += part[j];
    if ((tid & 15) == 15) grp[tid >> 4] = pre + loc;
    BLOCK_SYNC();
    for (int j = 0; j < (tid >> 4); ++j) pre += grp[j];
#pragma unroll
    for (int i = 0; i < PT; ++i) { const int p = tid * PT + i; pre += (double)v[i]; if (p < n) dst[p] = (float)pre; }
    BLOCK_SYNC();
}

DEV void knorm_unit(int tid, const bf16_t* Kb, int nkeys, unsigned* dst) {
    OPAQUE(tid);
    const int sub = tid & 15, kr = tid >> 4; float mx = 0.f;
    for (int k0 = 0; k0 < nkeys; k0 += 32) { const u32x4 t = *(const u32x4*)(Kb + (size_t)(k0 + kr) * HD + sub * 8); float s = 0.f;
#pragma unroll
        for (int e = 0; e < 4; ++e) { const float a = bf_lo(t[e]), b = bf_hi(t[e]); s += a * a + b * b; }
        s += SHFL_XOR(s, 1); s += SHFL_XOR(s, 2); s += SHFL_XOR(s, 4); s += SHFL_XOR(s, 8); mx = fmaxf(mx, s); }
    mx = fmaxf(mx, SHFL_XOR(mx, 16)); mx = fmaxf(mx, SHFL_XOR(mx, 32));
    if ((tid & 63) == 0) ATOMIC_MAX_U32(dst, __builtin_bit_cast(unsigned, mx));
}

constexpr int AT_K = 0, AT_VT = 17408, AT_DK = 35840, AT_FLAG = 36096, AT_END = 36160;
constexpr float PRUNE_T2 = 36.0f;
DEV void attn_block(LAS unsigned char* lds, int tid, const bf16_t* Q, const bf16_t* gate, bf16_t* O, const bf16_t* Kb, const bf16_t* Vb, const float* Dc, int qpos0, int nrows, float kmax) {
    OPAQUE(tid);
    const int lane = tid & 63, w = UNIFORM(tid >> 6), l16 = lane & 15, q4 = lane >> 4, dp = tid & 63, kg = w;
    const bool active = 32 * w < nrows;
    const int ntiles = (qpos0 + nrows + 63) >> 6;
    constexpr float C2 = 0.08838834764831845f * LOG2E;
    bf16x8 Qf[2][4]; float Dq2[2], mrun[2], lrun[2], cb[2]; f32x4 Oa[2][8];
#pragma unroll
    for (int qb = 0; qb < 2; ++qb) { const int r = active ? 32 * w + 16 * qb + l16 : 0;
#pragma unroll
        for (int st = 0; st < 4; ++st) Qf[qb][st] = *(const bf16x8*)(Q + (size_t)r * HD + 32 * st + 8 * q4);
        Dq2[qb] = Dc[qpos0 + r] * LOG2E; mrun[qb] = -1e30f; lrun[qb] = 0.f;
        { float q2 = 0.f;
#pragma unroll
          for (int st = 0; st < 4; ++st) { const u32x4 t = __builtin_bit_cast(u32x4, Qf[qb][st]);
#pragma unroll
              for (int e = 0; e < 4; ++e) { const float a = bf_lo(t[e]), b = bf_hi(t[e]); q2 += a * a + b * b; } }
          q2 += SHFL_XOR(q2, 16); q2 += SHFL_XOR(q2, 32); cb[qb] = sqrtf(q2) * kmax * C2 + Dq2[qb]; }
#pragma unroll
        for (int db = 0; db < 8; ++db) Oa[qb][db] = (f32x4){0.f, 0.f, 0.f, 0.f}; }
    u32x4 pk_[2]; unsigned pv[8]; float pd = 0.f;
    const int krow = tid >> 4, kc16 = tid & 15;
#define AT_LOAD(j) do { _Pragma("unroll") for (int i = 0; i < 2; ++i) pk_[i] = *(const u32x4*)(Kb + (size_t)(64 * (j) + krow + 32 * i) * HD + kc16 * 8); \
        _Pragma("unroll") for (int i = 0; i < 8; ++i) pv[i] = *(const unsigned*)(Vb + (size_t)(64 * (j) + 8 * kg + i) * HD + 2 * dp); \
        if (tid < 64) pd = Dc[64 * (j) + tid] * LOG2E; } while (0)
    AT_LOAD(ntiles - 1);
    const int ks_ = kg >> 2, kq = kg & 3, hb = kq >> 1;
    const int vpos0 = (32 * ks_ + 16 * (kq & 1) + 4 * hb) * 2, vpos1 = vpos0 + 16;
    if (tid < 8) *(LAS unsigned*)(lds + AT_FLAG + tid * 4) = 0u;
    bool wfin = false;
    for (int j = ntiles - 1; j >= 0; --j) {
        BLOCK_SYNC();
        { const u32x4 f0 = *(const LAS u32x4*)(lds + AT_FLAG), f1 = *(const LAS u32x4*)(lds + AT_FLAG + 16);
          if (UNIFORM((f0.x & f0.y & f0.z & f0.w & f1.x & f1.y & f1.z & f1.w) != 0u)) break; }
#pragma unroll
        for (int i = 0; i < 2; ++i) *(LAS u32x4*)(lds + AT_K + (krow + 32 * i) * 272 + kc16 * 16) = pk_[i];
        { u32x2 a, b;
          a.x = (pv[0] & 0xffffu) | (pv[1] << 16); a.y = (pv[2] & 0xffffu) | (pv[3] << 16); b.x = (pv[4] & 0xffffu) | (pv[5] << 16); b.y = (pv[6] & 0xffffu) | (pv[7] << 16);
          *(LAS u32x2*)(lds + AT_VT + (2 * dp) * 144 + vpos0) = a; *(LAS u32x2*)(lds + AT_VT + (2 * dp) * 144 + vpos1) = b;
          a.x = (pv[0] >> 16) | (pv[1] & 0xffff0000u); a.y = (pv[2] >> 16) | (pv[3] & 0xffff0000u); b.x = (pv[4] >> 16) | (pv[5] & 0xffff0000u); b.y = (pv[6] >> 16) | (pv[7] & 0xffff0000u);
          *(LAS u32x2*)(lds + AT_VT + (2 * dp + 1) * 144 + vpos0) = a; *(LAS u32x2*)(lds + AT_VT + (2 * dp + 1) * 144 + vpos1) = b; }
        if (tid < 64) *(LAS float*)(lds + AT_DK + tid * 4) = pd;
        BLOCK_SYNC();
        if (j > 0) AT_LOAD(j - 1);
        bool done = true;
        if (active && !wfin && 64 * j <= qpos0 + 32 * w + 31) {
            f32x4 s[2][4];
            { bf16x8 kf[2][4];
#pragma unroll
              for (int st = 0; st < 4; ++st) kf[0][st] = *(const LAS bf16x8*)(lds + AT_K + l16 * 272 + (32 * st + 8 * q4) * 2);
#pragma unroll
              for (int kb = 0; kb < 4; ++kb) {
                if (kb < 3) {
#pragma unroll
                    for (int st = 0; st < 4; ++st) kf[(kb + 1) & 1][st] = *(const LAS bf16x8*)(lds + AT_K + (16 * (kb + 1) + l16) * 272 + (32 * st + 8 * q4) * 2); }
#pragma unroll
                for (int qb = 0; qb < 2; ++qb) { f32x4 acc = {0.f, 0.f, 0.f, 0.f};
#pragma unroll
                    for (int st = 0; st < 4; ++st) acc = MFMA16(kf[kb & 1][st], Qf[qb][st], acc);
                    s[qb][kb] = acc; } SCHED_FENCE(); } }
            const bool need_mask = 64 * j + 63 > qpos0 + 32 * w;
#pragma unroll
            for (int qb = 0; qb < 2; ++qb) { const int qpos = qpos0 + 32 * w + 16 * qb + l16; float mx = -__builtin_inff();
#pragma unroll
                for (int kb = 0; kb < 4; ++kb) { const f32x4 dk = *(const LAS f32x4*)(lds + AT_DK + (16 * kb + 4 * q4) * 4);
#pragma unroll
                    for (int r = 0; r < 4; ++r) { float v = s[qb][kb][r] * C2 + (Dq2[qb] - dk[r]); if (need_mask && 64 * j + 16 * kb + 4 * q4 + r > qpos) v = -__builtin_inff(); s[qb][kb][r] = v; mx = fmaxf(mx, v); } }
                mx = fmaxf(mx, SHFL_XOR(mx, 16)); mx = fmaxf(mx, SHFL_XOR(mx, 32));
                const float mn = fmaxf(mrun[qb], mx); float ps = 0.f;
#pragma unroll
                for (int kb = 0; kb < 4; ++kb)
#pragma unroll
                    for (int r = 0; r < 4; ++r) { const float p = fexp2(s[qb][kb][r] - mn); s[qb][kb][r] = p; ps += p; }
                if (WAVE_ALL(mn == mrun[qb])) lrun[qb] += ps;
                else { const float alpha = fexp2(mrun[qb] - mn); mrun[qb] = mn; lrun[qb] = lrun[qb] * alpha + ps;
#pragma unroll
                    for (int db = 0; db < 8; ++db) Oa[qb][db] = Oa[qb][db] * alpha; } }
            bf16x8 pf[2][2];
#pragma unroll
            for (int qb = 0; qb < 2; ++qb)
#pragma unroll
                for (int ks = 0; ks < 2; ++ks) { u32x4 t; t.x = pk2(s[qb][2 * ks][0], s[qb][2 * ks][1]); t.y = pk2(s[qb][2 * ks][2], s[qb][2 * ks][3]); t.z = pk2(s[qb][2 * ks + 1][0], s[qb][2 * ks + 1][1]); t.w = pk2(s[qb][2 * ks + 1][2], s[qb][2 * ks + 1][3]);
                    pf[qb][ks] = __builtin_bit_cast(bf16x8, t); }
            { bf16x8 vf[2][2];
#pragma unroll
              for (int ks = 0; ks < 2; ++ks) vf[0][ks] = *(const LAS bf16x8*)(lds + AT_VT + l16 * 144 + (32 * ks + 8 * q4) * 2);
#pragma unroll
              for (int db = 0; db < 8; ++db) {
                if (db < 7) {
#pragma unroll
                    for (int ks = 0; ks < 2; ++ks) vf[(db + 1) & 1][ks] = *(const LAS bf16x8*)(lds + AT_VT + (16 * (db + 1) + l16) * 144 + (32 * ks + 8 * q4) * 2); }
#pragma unroll
                for (int ks = 0; ks < 2; ++ks)
#pragma unroll
                    for (int qb = 0; qb < 2; ++qb) Oa[qb][db] = MFMA16(vf[db & 1][ks], pf[qb][ks], Oa[qb][db]);
                SCHED_FENCE(); } }
        }
        if (active) { const float dk0 = *(const LAS float*)(lds + AT_DK);
            done = (cb[0] - dk0 - mrun[0] < -PRUNE_T2) && (cb[1] - dk0 - mrun[1] < -PRUNE_T2); }
        { const bool wdone = wfin || WAVE_ALL(done); wfin = wdone; if (lane == 0) *(LAS unsigned*)(lds + AT_FLAG + w * 4) = wdone ? 1u : 0u; }
    }
#undef AT_LOAD
    if (active) {
#pragma unroll
        for (int qb = 0; qb < 2; ++qb) { float l = lrun[qb]; l += SHFL_XOR(l, 16); l += SHFL_XOR(l, 32); const float inv = 1.0f / l; const size_t ro = (size_t)(32 * w + 16 * qb + l16) * D, rg = (size_t)(32 * w + 16 * qb + l16) * HD;
            u32x2 gt[8];
#pragma unroll
            for (int db = 0; db < 8; ++db) gt[db] = *(const u32x2*)(gate + rg + 16 * db + 4 * q4);
#pragma unroll
            for (int db = 0; db < 8; ++db) { const f32x4 ov = Oa[qb][db] * inv;
                *(u32x2*)(O + ro + 16 * db + 4 * q4) = (u32x2){pk2(ov[0] * bf_lo(gt[db].x), ov[1] * bf_hi(gt[db].x)), pk2(ov[2] * bf_lo(gt[db].y), ov[3] * bf_hi(gt[db].y))}; } }
    }
    BLOCK_SYNC();
}
#ifndef EMU_HOST
#define RLX_AGENT __ATOMIC_RELAXED, __HIP_MEMORY_SCOPE_AGENT
#define LDS_WAIT() asm volatile("s_waitcnt lgkmcnt(0)" ::: "memory")
typedef GAS unsigned gu32;
#define XB_TMO      128
#define XB_XCNT(j)  (256  + 64 * (j))
#define XB_XSUB(j)  (1280 + 64 * (j))
#define XB_XGEN(j)  (2304 + 64 * (j))
#define XB_TOP      3328
#define XB_TOPGEN   3392
#define XCD_BAR_WORDS 3456
#define XB_SPIN_CAP (1u << 18)

__device__ __forceinline__ unsigned xb_ld(unsigned* p)              { return __hip_atomic_load(p, __ATOMIC_RELAXED, __HIP_MEMORY_SCOPE_AGENT); }
__device__ __forceinline__ unsigned xb_add(unsigned* p, unsigned v) { return __hip_atomic_fetch_add(p, v, __ATOMIC_RELAXED, __HIP_MEMORY_SCOPE_AGENT); }
__device__ __forceinline__ unsigned xb_xcc_id() { return (unsigned)__builtin_amdgcn_s_getreg((3 << 11) | 20) & 0xFu; }
#define XB_SPIN(cond, bar) do { unsigned _sp = 0; while (cond) { __builtin_amdgcn_s_sleep(1); \
    if ((++_sp & 255u) == 0u) { if (xb_ld(&(bar)[XB_TMO])) break; if (_sp > XB_SPIN_CAP) { atomicAdd(&(bar)[XB_TMO], 1u); break; } } } } while (0)

struct XcdBarrier {
    unsigned* bar; unsigned x;
    volatile LAS unsigned* st;
};

__device__ __forceinline__ XcdBarrier xcd_barrier_post(unsigned* bar, volatile LAS unsigned* st) {
    XcdBarrier b; b.bar = bar; b.x = xb_xcc_id(); b.st = st;
    if (threadIdx.x == 0) (void)xb_add(&bar[XB_XCNT(b.x)], 1u);
    return b;
}
__device__ __forceinline__ void xcd_barrier_complete(unsigned* bar, unsigned x, unsigned& nloc, unsigned& nx) {
    const unsigned G = gridDim.x * gridDim.y * gridDim.z;
    unsigned sum, cnt, mine, sp = 0u;
    for (;;) {
        sum = 0u; cnt = 0u; mine = 0u;
#pragma unroll
        for (unsigned j = 0; j < 16; ++j) { const unsigned c = xb_ld(&bar[XB_XCNT(j)]); sum += c; cnt += (c > 0u) ? 1u : 0u; mine = (j == x) ? c : mine; }
        if (sum == G) break;
        __builtin_amdgcn_s_sleep(1);
        if ((++sp & 255u) == 0u) { if (xb_ld(&bar[XB_TMO])) break; if (sp > XB_SPIN_CAP) { atomicAdd(&bar[XB_TMO], 1u); break; } }
    }
    nloc = mine > 0u ? mine : 1u; nx = cnt > 0u ? cnt : 1u;
}

__device__ __forceinline__ void xcd_barrier(const XcdBarrier& b) {
    asm volatile("s_waitcnt vmcnt(0)" ::: "memory");
    __syncthreads();
    if (threadIdx.x == 0) {
        unsigned* bar = b.bar;
        __builtin_amdgcn_s_waitcnt(0);
        unsigned nloc = b.st[0], nx = b.st[1];
        if (nloc == 0u) { xcd_barrier_complete(bar, b.x, nloc, nx); b.st[0] = nloc; b.st[1] = nx; }
        const unsigned old = xb_add(&bar[XB_XSUB(b.x)], 1u);
        const unsigned gen = old / nloc;
        if (old + 1u == (gen + 1u) * nloc) {
            __builtin_amdgcn_fence(__ATOMIC_RELEASE, "agent");
            asm volatile("s_waitcnt vmcnt(0)" ::: "memory");
            const unsigned og = xb_add(&bar[XB_TOP], 1u);
            const unsigned tg = og / nx;
            if (og + 1u == (tg + 1u) * nx) xb_add(&bar[XB_TOPGEN], 1u);
            else XB_SPIN(xb_ld(&bar[XB_TOPGEN]) == tg, bar);
            __builtin_amdgcn_fence(__ATOMIC_ACQUIRE, "agent");
            xb_add(&bar[XB_XGEN(b.x)], 1u);
            asm volatile("s_waitcnt vmcnt(0)" ::: "memory");
        } else {
            XB_SPIN(xb_ld(&bar[XB_XGEN(b.x)]) == gen, bar);
            __builtin_amdgcn_fence(__ATOMIC_ACQUIRE, "agent");
            asm volatile("s_waitcnt vmcnt(0)" ::: "memory");
        }
    }
    __syncthreads();
}


__device__ __forceinline__ void p0_transpose_item(const float* W, int K, int N, int pitch, const float* gain, bf16_t* WT, int row_off, LAS float* scr, int item, int lane) {
    const int nblk = N / 32, kb = item / nblk, nb = item % nblk, k0 = 64 * kb, n0 = 32 * nb;
#pragma unroll 8
    for (int i = 0; i < 32; ++i) { const int kk = 2 * i + (lane >> 5); const float gk = gain ? gain[k0 + kk] : 1.0f; scr[kk * 33 + (lane & 31)] = W[(size_t)(k0 + kk) * pitch + n0 + (lane & 31)] * gk; }
    LDS_WAIT(); asm volatile("" ::: "memory");
    const int c = lane & 7;
#pragma unroll
    for (int j = 0; j < 4; ++j) { const int n = (lane >> 3) + 8 * j; const LAS float* s = scr + (8 * c) * 33 + n;
        u32x4 o; o.x = pk2(s[0 * 33], s[1 * 33]); o.y = pk2(s[2 * 33], s[3 * 33]); o.z = pk2(s[4 * 33], s[5 * 33]); o.w = pk2(s[6 * 33], s[7 * 33]);
        *(u32x4*)(WT + (size_t)(row_off + n0 + n) * K + k0 + 8 * c) = o; }
    LDS_WAIT(); asm volatile("" ::: "memory");
}
__device__ __forceinline__ float wave_sum(float v) {
#pragma unroll
    for (int o = 1; o < 64; o <<= 1) v += __shfl_xor(v, o);
    return v;
}

#ifndef SITES
#define SITES 0xFFFF
#endif
#define SITE(k) ((SITES >> (k)) & 1)
#ifndef PROBE_SITES
#define PROBE_SITES 0
#endif
#define NREP(k) (((PROBE_SITES >> (k)) & 1) ? 2 : 1)
struct Args { const float* in[23]; float* out; unsigned char* ws; int ph_lo, ph_hi; };
constexpr int N_PHASES = 26;
__host__ __device__ constexpr bool phase_nonempty(int p) { return !(p == 15 || p == 20 || p == 21); }

__global__ void __launch_bounds__(NWAVES * 64, 2) fwd(Args args) {
    extern __shared__ __attribute__((aligned(16))) unsigned char lds_raw[];
    LAS unsigned char* lds = (LAS unsigned char*)lds_raw;
    volatile LAS unsigned* MISC = (volatile LAS unsigned*)(lds + MISC_OFF);
    const int wave0 = __builtin_amdgcn_readfirstlane(threadIdx.x >> 6);
    const int G = gridDim.x, bx = blockIdx.x, vcu = (G % 8 == 0) ? (bx % 8) * (G / 8) + bx / 8 : bx;
    gu32* ctl = (gu32*)(args.ws + WS_CTL);
    for (int u = threadIdx.x; u < (LDS_BYTES - LDSCTL_OFF) / 4; u += NWAVES * 64) ((LAS unsigned*)(lds + LDSCTL_OFF))[u] = 0u;
    __syncthreads();
    const bool one_launch = (args.ph_lo == 0 && args.ph_hi == N_PHASES);
    XcdBarrier bar; bar.bar = (unsigned*)(ctl + CW_BAR); bar.x = 0; bar.st = nullptr;
    if (one_launch) bar = xcd_barrier_post((unsigned*)(ctl + CW_BAR), MISC + 8);
    const int lo = args.ph_lo, hi = args.ph_hi;
#define IN(k) (lo <= (k) && (k) < hi)
#define SEAM(k) do { if ((k) + 1 < hi) xcd_barrier(bar); } while (0)
#define SITE_FRAME() int tid; asm volatile("v_mbcnt_lo_u32_b32 %0, -1, 0\n\tv_mbcnt_hi_u32_b32 %0, -1, %0" : "=v"(tid)); tid += wave0 * 64; GAS unsigned char* wsb = (GAS unsigned char*)args.ws; asm volatile("" : "+s"(wsb)); \
    const int lane = tid & 63, wave = wave0, gw = vcu * NWAVES + wave, NGW = G * NWAVES, gtid = vcu * (NWAVES * 64) + tid, GT = G * NWAVES * 64; \
    (void)lane; (void)wave; (void)gw; (void)NGW; (void)gtid; (void)GT; (void)wsb
#define x_prompt (args.in[0])
#define x_sample (args.in[1])
#define state_hgrn (args.in[2])
#define cache_k (args.in[3])
#define cache_v (args.in[4])
#define cache_logf (args.in[5])
#define p_prompt (args.in[6])
#define p_sample (args.in[7])
#define g_norm_a (args.in[8])
#define w_in_a (args.in[9])
#define lb_logits (args.in[10])
#define g_out_a (args.in[11])
#define w_out_a (args.in[12])
#define g_kv (args.in[13])
#define w_kv (args.in[14])
#define b_f (args.in[15])
#define g_norm_b (args.in[16])
#define w_in_b (args.in[17])
#define w_out_b (args.in[18])
#define w_ple_in (args.in[19])
#define g_ple (args.in[20])
#define w_ple_gate (args.in[21])
#define g_final (args.in[22])
#define ss ((float*)(wsb + WS_SS))
#define lbv ((float*)(wsb + WS_LBV))
#define gseg ((float*)(wsb + WS_GSEG))
#define Dp ((float*)(wsb + WS_DP))
#define Ds ((float*)(wsb + WS_DS))
#define LF ((float*)(wsb + WS_LF))
#define W_AIN ((bf16_t*)(wsb + WS_WAIN))
#define W_AOUT ((bf16_t*)(wsb + WS_WAOUT))
#define W_KVQ ((bf16_t*)(wsb + WS_WKVQ))
#define W_BIN1 ((bf16_t*)(wsb + WS_WBIN1))
#define W_BOUT ((bf16_t*)(wsb + WS_WBOUT))
#define W_PIN ((bf16_t*)(wsb + WS_WPIN))
#define W_PG ((bf16_t*)(wsb + WS_WPG))
#define X ((float*)(wsb + WS_X))
#define XB ((bf16_t*)(wsb + WS_XB))
#define XB2 ((bf16_t*)(wsb + WS_XB2))
#define ZQ ((bf16_t*)(wsb + WS_ZQ))
#define ZG ((bf16_t*)(wsb + WS_ZG))
#define ZV ((bf16_t*)(wsb + WS_ZV))
#define ZGATE ((bf16_t*)(wsb + WS_ZGATE))
#define OB ((bf16_t*)(wsb + WS_OB))
#define EB ((bf16_t*)(wsb + WS_EB))
#define PB ((bf16_t*)(wsb + WS_PB))
#define KS ((bf16_t*)(wsb + WS_KS))
#define VS ((bf16_t*)(wsb + WS_VS))
#define KP ((bf16_t*)(wsb + WS_KP))
#define VP ((bf16_t*)(wsb + WS_VP))
#define LSEG ((float*)(wsb + WS_LSEG))
#define SSTART ((float*)(wsb + WS_SSTART))
#define out (args.out)
    if (SITE(10) && IN(0)) { SITE_FRAME();
        for (int rep = 0; rep < NREP(10); ++rep) {
        LAS float* scr = (LAS float*)(lds + wave * 16384);
        constexpr int I_AIN = 32 * 256, I_SQ = 32 * 64, I_KV = 32 * 128, I_PIN = 4 * 64;
        constexpr int NITEMS = 2 * I_AIN + 2 * I_SQ + 3 * I_KV + 2 * I_SQ + 4 * I_PIN + 4 * I_SQ;
        for (int it = gw; it < NITEMS; it += NGW) {
            int r = it;
            if (r < 2 * I_AIN) { const int l = r / I_AIN; p0_transpose_item(w_in_a + (size_t)l * D * 4 * D, D, 4 * D, 4 * D, g_norm_a + l * D, W_AIN + (size_t)l * 4 * D * D, 0, scr, r % I_AIN, lane); continue; } r -= 2 * I_AIN;
            if (r < 2 * I_SQ) { const int l = r / I_SQ; p0_transpose_item(w_out_a + (size_t)l * D * D, D, D, D, nullptr, W_AOUT + (size_t)l * D * D, 0, scr, r % I_SQ, lane); continue; } r -= 2 * I_SQ;
            if (r < I_KV) { p0_transpose_item(w_kv, D, 2 * D, 2 * D + H, g_kv, W_KVQ, 0, scr, r, lane); continue; } r -= I_KV;
            if (r < I_KV) { p0_transpose_item(w_in_b, D, 2 * D, 2 * D, g_norm_b, W_KVQ, 2 * D, scr, r, lane); continue; } r -= I_KV;
            if (r < I_KV) { p0_transpose_item(w_in_b + (size_t)D * 2 * D, D, 2 * D, 2 * D, g_norm_b + D, W_BIN1, 0, scr, r, lane); continue; } r -= I_KV;
            if (r < 2 * I_SQ) { const int l = r / I_SQ; p0_transpose_item(w_out_b + (size_t)l * D * D, D, D, D, nullptr, W_BOUT + (size_t)l * D * D, 0, scr, r % I_SQ, lane); continue; } r -= 2 * I_SQ;
            if (r < 4 * I_PIN) { const int l = r / I_PIN; p0_transpose_item(w_ple_in + (size_t)l * DPLE * D, DPLE, D, D, nullptr, W_PIN + (size_t)l * D * DPLE, 0, scr, r % I_PIN, lane); continue; } r -= 4 * I_PIN;
            { const int l = r / I_SQ; p0_transpose_item(w_ple_gate + (size_t)l * D * D, D, D, D, g_ple + l * D, W_PG + (size_t)l * D * D, 0, scr, r % I_SQ, lane); }
        }
        for (int e = gtid; e < 256 * D; e += GT) { const int n = e / D, k = e % D; W_KVQ[(size_t)(4 * D + n) * D + k] = n < H ? (bf16_t)(pk2(g_kv[k] * w_kv[(size_t)k * (2 * D + H) + 2 * D + n], 0.f) & 0xffffu) : (bf16_t)0; }
        for (int m = gw; m < M; m += NGW) { const float* xr = m < MP ? x_prompt + (size_t)m * D : x_sample + (size_t)(m - MP) * D; float s = 0.f;
#pragma unroll
            for (int j = 0; j < 8; ++j) { const f32x4 v = *(const f32x4*)(xr + 256 * j + 4 * lane); s += (v[0] * v[0] + v[1] * v[1]) + (v[2] * v[2] + v[3] * v[3]);
                *(u32x2*)(XB + (size_t)m * D + 256 * j + 4 * lane) = (u32x2){pk2(v[0], v[1]), pk2(v[2], v[3])}; }
            s = wave_sum(s); if (lane == 0) ss[m] = s; }
        for (size_t e = (size_t)gtid * 8; e < (size_t)4 * M * DPLE; e += (size_t)GT * 8) { const int l = (int)(e / ((size_t)M * DPLE)); const size_t r = e % ((size_t)M * DPLE); const int m = (int)(r / DPLE), c = (int)(r % DPLE);
            const float* src = m < MP ? p_prompt + ((size_t)l * MP + m) * DPLE + c : p_sample + ((size_t)l * MS + (m - MP)) * DPLE + c;
            const f32x4 a = *(const f32x4*)src, b = *(const f32x4*)(src + 4); *(u32x4*)(PB + e) = (u32x4){pk2(a[0], a[1]), pk2(a[2], a[3]), pk2(b[0], b[1]), pk2(b[2], b[3])}; }
        for (size_t e = (size_t)gtid * 8; e < (size_t)NBS * PAST * D; e += (size_t)GT * 8) { const size_t r = e / D; const int c = (int)(e % D); const size_t b = r / PAST, pos = r % PAST; const size_t d = ((size_t)(c >> 7) * NBS * LKS + b * LKS + pos) * HD + (c & 127);
            { const f32x4 a = *(const f32x4*)(cache_k + e), bb = *(const f32x4*)(cache_k + e + 4); *(u32x4*)(KS + d) = (u32x4){pk2(a[0], a[1]), pk2(a[2], a[3]), pk2(bb[0], bb[1]), pk2(bb[2], bb[3])}; }
            { const f32x4 a = *(const f32x4*)(cache_v + e), bb = *(const f32x4*)(cache_v + e + 4); *(u32x4*)(VS + d) = (u32x4){pk2(a[0], a[1]), pk2(a[2], a[3]), pk2(bb[0], bb[1]), pk2(bb[2], bb[3])}; } }
        for (int c = gtid; c < D; c += GT) { lbv[c] = 0.f; lbv[D + c] = 1.0f / (1.0f + expf(lb_logits[c] - lb_logits[D + c])); }
        }
        SEAM(0);
    }

#pragma unroll 1
    for (int L = 0; L < 4; ++L) {
        const int pb = 1 + 6 * L; const bool isA = L < 2; const int j = L - 2;
        if (IN(pb)) { SITE_FRAME();
            if (SITE(0) && isA) for (int rep = 0; rep < NREP(0); ++rep) { pg8::Gemm g{XB, W_AIN + (size_t)L * 4 * D * D, M, 4 * D, D}; pg8::StaticOrder S; S.init(M, 4 * D, G, bx);
                pg8::EpiAin E{ss + (size_t)(2 * L) * M, lbv + L * D, ZQ, ZG, ZV, ZGATE};
                pg8::gemm_phase<pg8::EpiAin, pg8::StaticOrder, true, true>(lds, g, S, E, wave0);
            } else if (SITE(1) && !isA) for (int rep = 0; rep < NREP(1); ++rep) { const int N = (j == 0) ? NKVQ : 2 * D; pg8::Gemm g{XB, j == 0 ? W_KVQ : W_BIN1, M, N, D}; pg8::StaticOrder S; S.init(M, N, G, bx);
                pg8::EpiBin E{ss + (size_t)(2 * L) * M, j == 0 ? 0 : 2, KP, VP, KS, VS, ZQ, ZGATE, out, LF, b_f};
                pg8::gemm_phase<pg8::EpiBin, pg8::StaticOrder, true, true>(lds, g, S, E, wave0); }
            if (SITE(2)) for (int rep = 0; rep < NREP(2); ++rep) { int kple = DPLE; asm volatile("" : "+s"(kple));
              pg8::Gemm g{PB + (size_t)L * M * DPLE, W_PIN + (size_t)L * D * DPLE, M, D, kple}; pg8::StaticOrder S; S.init(M, D, G, bx);
              pg8::EpiBf16 E{EB, D};
              pg8::gemm_phase<pg8::EpiBf16, pg8::StaticOrder, true, true>(lds, g, S, E, wave0); }
            SEAM(pb);
        }
        if (IN(pb + 1) && phase_nonempty(pb + 1)) { SITE_FRAME();
            if (SITE(3) && isA) for (int rep = 0; rep < NREP(3); ++rep) {
                for (int u = vcu; u < 32 * (NSEG - 1); u += G) { const int stream = u / (NSEG - 1), seg = u % (NSEG - 1), b = stream >> 4, h = stream & 15;
                    hgrn_unit<false>(lds, tid, nullptr, ZG + (size_t)h * M * HD, ZV + (size_t)h * M * HD, nullptr, nullptr, nullptr, b * TP + seg * (SEGC * CH), SEGC, h, nullptr, LSEG + ((size_t)(stream * NSEG + seg) << 14), gseg + (size_t)(stream * NSEG + seg) * HD); }
            } else if (SITE(4) && !isA) for (int rep = 0; rep < NREP(4); ++rep) {
                for (int u = vcu; u < 512 + 256; u += G) {
                    if (u < 512) { const int bh = u >> 4, c = u & 15, b = bh >> 4, h = bh & 15; knorm_unit(tid, KP + ((size_t)h * MP + (size_t)b * TP + c * 1024) * HD, 1024, (unsigned*)(wsb + WS_CTL) + CW_KMAX + bh); }
                    else { const int v = u - 512, b = v >> 4, h = v & 15; knorm_unit(tid, KS + ((size_t)h * NBS + b) * LKS * HD, LKS, (unsigned*)(wsb + WS_CTL) + CW_KMAX + 32 + v); } }
                for (int u = vcu; u < 32 + 256; u += G) {
                    if (u < 32) { const int b = u >> 4, h = u & 15; cumsum_unit<32>(lds, tid, LF + (size_t)b * TP * H + h, TP, H, nullptr, 0, TP, Dp + (size_t)u * TP); }
                    else { const int v = u - 32, b = v >> 4, h = v & 15; cumsum_unit<3>(lds, tid, cache_logf + (size_t)b * PAST * H + h, PAST, H, LF + (size_t)(MP + b * TS) * H + h, H, LKS, Ds + (size_t)v * LKS); } }
            }
            SEAM(pb + 1);
        }
        if (SITE(5) && IN(pb + 2) && phase_nonempty(pb + 2)) { SITE_FRAME(); for (int rep = 0; rep < NREP(5); ++rep) hgrn_scan(gtid, GT, LSEG, gseg, SSTART); SEAM(pb + 2); }
        if (IN(pb + 3)) { SITE_FRAME();
            if (SITE(6) && isA) for (int rep = 0; rep < NREP(6); ++rep) {
                for (int u = vcu; u < 32 * NSEG + NBS * H; u += G) {
                    if (u < 32 * NSEG) { const int stream = u / NSEG, seg = u % NSEG, b = stream >> 4, h = stream & 15;
                        hgrn_unit<true>(lds, tid, ZQ + (size_t)h * M * HD, ZG + (size_t)h * M * HD, ZV + (size_t)h * M * HD, ZGATE + (size_t)h * M * HD, g_out_a + L * D, OB, b * TP + seg * (SEGC * CH), SEGC, h, seg ? SSTART + ((size_t)(stream * NSEG + seg) << 14) : nullptr,
                                        seg == NSEG - 1 ? out + O_STP + ((size_t)(L * NBP * H + stream) << 14) : nullptr, nullptr); }
                    else { const int v = u - 32 * NSEG, b = v >> 4, h = v & 15;
                        hgrn_unit<true>(lds, tid, ZQ + (size_t)h * M * HD, ZG + (size_t)h * M * HD, ZV + (size_t)h * M * HD, ZGATE + (size_t)h * M * HD, g_out_a + L * D, OB, MP + b * TS, 1, h, state_hgrn + ((size_t)(L * NBS * H + v) << 14), out + O_STS + ((size_t)(L * NBS * H + v) << 14), nullptr); } }
            } else if (SITE(7) && !isA) for (int rep = 0; rep < NREP(7); ++rep) {
                const float* kmx = (const float*)(wsb + WS_CTL) + CW_KMAX;
                for (int u = vcu; u < 2048 + 256; u += G) {
                    if (u < 2048) { const int bh = u >> 6, qb = u & 63, b = bh >> 4, h = bh & 15; const size_t r0 = (size_t)b * TP + 256 * qb, hq = ((size_t)h * M + r0) * HD, hk = ((size_t)h * MP + (size_t)b * TP) * HD;
                        attn_block(lds, tid, ZQ + hq, ZGATE + hq, OB + r0 * D + h * HD, KP + hk, VP + hk, Dp + (size_t)bh * TP, 256 * qb, 256, sqrtf(kmx[bh])); }
                    else { const int v = u - 2048, b = v >> 4, h = v & 15; const size_t r0 = (size_t)MP + b * TS, hq = ((size_t)h * M + r0) * HD, hk = ((size_t)h * NBS + b) * LKS * HD;
                        attn_block(lds, tid, ZQ + hq, ZGATE + hq, OB + r0 * D + h * HD, KS + hk, VS + hk, Ds + (size_t)v * LKS, PAST, TS, sqrtf(kmx[32 + v])); } }
            }
            SEAM(pb + 3);
        }
        if (SITE(8) && IN(pb + 4)) { SITE_FRAME(); pg8::Gemm g{OB, (isA ? W_AOUT + (size_t)L * D * D : W_BOUT + (size_t)j * D * D), M, D, D}; pg8::StaticOrder S; S.init(M, D, G, bx);
            pg8::EpiRes<false> E{L == 0 ? x_prompt : X, L == 0 ? x_sample : X + (size_t)MP * D, X, X + (size_t)MP * D, XB2, ss + (size_t)(2 * L + 1) * M, nullptr, nullptr};
            pg8::gemm_phase<pg8::EpiRes<false>, pg8::StaticOrder, true, true>(lds, g, S, E, wave0);
            SEAM(pb + 4); }
        if (SITE(9) && IN(pb + 5)) { SITE_FRAME(); pg8::Gemm g{XB2, W_PG + (size_t)L * D * D, M, D, D}; pg8::StaticOrder S; S.init(M, D, G, bx);
            pg8::EpiRes<true> E{X, X + (size_t)MP * D, L == 3 ? out + O_YP : X, L == 3 ? out + O_YS : X + (size_t)MP * D, XB, ss + (size_t)(2 * L + 2) * M, ss + (size_t)(2 * L + 1) * M, EB};
            pg8::gemm_phase<pg8::EpiRes<true>, pg8::StaticOrder, true, true>(lds, g, S, E, wave0);
            SEAM(pb + 5); }
    }
    if (SITE(11) && IN(25)) { SITE_FRAME();
        const float* s8 = ss + (size_t)8 * M;
        for (int m = gw; m < M; m += NGW) { float* yr = out + O_YP + (size_t)m * D; const float rstd = frsq(s8[m] * (1.0f / D) + EPS);
#pragma unroll
            for (int jj = 0; jj < 8; ++jj) { const int c = 256 * jj + 4 * lane; const f32x4 v = *(const f32x4*)(yr + c), gv = *(const f32x4*)(g_final + c); *(f32x4*)(yr + c) = v * rstd * gv; } }
    }
#undef IN
#undef SEAM
}
#undef x_prompt
#undef x_sample
#undef state_hgrn
#undef cache_k
#undef cache_v
#undef cache_logf
#undef p_prompt
#undef p_sample
#undef g_norm_a
#undef w_in_a
#undef lb_logits
#undef g_out_a
#undef w_out_a
#undef g_kv
#undef w_kv
#undef b_f
#undef g_norm_b
#undef w_in_b
#undef w_out_b
#undef w_ple_in
#undef g_ple
#undef w_ple_gate
#undef g_final
#undef ss
#undef lbv
#undef gseg
#undef Dp
#undef Ds
#undef LF
#undef W_AIN
#undef W_AOUT
#undef W_KVQ
#undef W_BIN1
#undef W_BOUT
#undef W_PIN
#undef W_PG
#undef X
#undef XB
#undef XB2
#undef ZQ
#undef ZG
#undef ZV
#undef ZGATE
#undef OB
#undef EB
#undef PB
#undef KS
#undef VS
#undef KP
#undef VP
#undef LSEG
#undef SSTART
#undef out

extern "C" void kernel_launch(void* const* d_in, const int* in_sizes, int n_in, void* d_out, int out_size, void* d_ws, size_t ws_size, hipStream_t stream) {
    static int grid = 0;
    if (grid == 0) {
        if (n_in != 23 || (size_t)out_size != O_END || ws_size < WS_END) { fprintf(stderr, "kernel_launch: unexpected shapes (n_in %d, out %d, ws %zu); nothing launched\n", n_in, out_size, ws_size); grid = -1; return; }
        int dev = 0, cus = 0, per_cu = 0;
        if (hipGetDevice(&dev) != hipSuccess || hipDeviceGetAttribute(&cus, hipDeviceAttributeMultiprocessorCount, dev) != hipSuccess) { grid = -1; return; }
        if (hipFuncSetAttribute((const void*)fwd, hipFuncAttributeMaxDynamicSharedMemorySize, LDS_BYTES) != hipSuccess) { fprintf(stderr, "kernel_launch: hipFuncSetAttribute failed\n"); grid = -1; return; }
        if (hipOccupancyMaxActiveBlocksPerMultiprocessor(&per_cu, (const void*)fwd, NWAVES * 64, LDS_BYTES) != hipSuccess || per_cu < 1) { fprintf(stderr, "kernel_launch: occupancy query says %d\n", per_cu); }
        (void)hipGetLastError();
        grid = cus;
    }
    if (grid < 0) return;
    (void)hipMemsetAsync((char*)d_ws + WS_CTL, 0, CTL_ZERO_BYTES, stream);
    Args a{};
    for (int i = 0; i < 23; ++i) a.in[i] = (const float*)d_in[i];
    a.out = (float*)d_out; a.ws = (unsigned char*)d_ws;
#ifndef MK_PER_PHASE
    a.ph_lo = 0; a.ph_hi = N_PHASES;
    hipLaunchKernelGGL(fwd, dim3(grid), dim3(NWAVES * 64), LDS_BYTES, stream, a);
#else
    for (int p = 0; p < N_PHASES; ++p) { if (!phase_nonempty(p)) continue; a.ph_lo = p; a.ph_hi = p + 1; hipLaunchKernelGGL(fwd, dim3(grid), dim3(NWAVES * 64), LDS_BYTES, stream, a); }
#endif
}
#endif
```
